# Optimizing an MI355X kernel written in HIP

```python
import math
import jax, jax.numpy as jnp
from jax import lax
import numpy as np

D_MODEL = 1024
BATCH = 2
SEQ = 16384
DEPTH = 2

N_HEADS = 8
HEAD_DIM = 64
V_HEAD_DIM = 2 * HEAD_DIM
ATTN_QK_W = N_HEADS * 2 * HEAD_DIM
ATTN_V_W = N_HEADS * V_HEAD_DIM
Q_BLOCK = 128
CONV_W = 1024
CONV_K = 3
NUM_BUCKETS = 32
MAX_DISTANCE = 128
FF_DENSE = 2816
N_EXPERTS = 8
TOP_K = 2
FF_EXPERT = 3584
RMS_EPS = 1e-6
IN_W = 2 * ATTN_QK_W + ATTN_V_W + 3 * CONV_W + 2 * D_MODEL
N_DENSE_LAYERS = (DEPTH + 1) // 2
N_MOE_LAYERS = DEPTH // 2

kernel_name = "hybrid_diffattn_shortconv_moe_trunk"


def lambda_init_fn(layer_idx):
    return 0.8 - 0.6 * math.exp(-0.3 * layer_idx)


def rmsnorm(x, g):
    xf = x.astype(jnp.float32)
    y = xf * lax.rsqrt(jnp.mean(xf * xf, axis=-1, keepdims=True) + RMS_EPS)
    return (y * g.astype(jnp.float32)).astype(x.dtype)


def t5_causal_bucket(dist):
    max_exact = NUM_BUCKETS // 2
    is_small = dist < max_exact
    d = jnp.maximum(dist, 1).astype(jnp.float32)
    large = max_exact + (jnp.log(d / max_exact) / math.log(MAX_DISTANCE / max_exact)
                         * (NUM_BUCKETS - max_exact)).astype(jnp.int32)
    large = jnp.minimum(large, NUM_BUCKETS - 1)
    return jnp.where(is_small, dist, large)


def diff_attention(q, k, v, bias_dist, lam, lam_init, subln_g):
    B, S = q.shape[0], q.shape[1]
    nblk = S // Q_BLOCK
    scale = HEAD_DIM ** -0.5
    qb = q.reshape(B, nblk, Q_BLOCK, N_HEADS, 2, HEAD_DIM).swapaxes(0, 1)
    kf = k.astype(jnp.float32)
    vf = v.astype(jnp.float32)
    kpos = jnp.arange(S, dtype=jnp.int32)
    g = subln_g.astype(jnp.float32) * (1.0 - lam_init)

    def one_block(args):
        blk, qblk = args
        qpos = blk * Q_BLOCK + jnp.arange(Q_BLOCK, dtype=jnp.int32)
        dist = qpos[:, None] - kpos[None, :]
        bias = bias_dist[:, jnp.maximum(dist, 0)]
        s = jnp.einsum('bqhmd,bkhmd->bhmqk', qblk.astype(jnp.float32) * scale, kf)
        s = s + bias[None, :, None]
        s = jnp.where(dist >= 0, s, -jnp.inf)
        p = jax.nn.softmax(s, axis=-1)
        w = p[:, :, 0] - lam * p[:, :, 1]
        o = jnp.einsum('bhqk,bkhe->bqhe', w, vf)
        o = o * lax.rsqrt(jnp.mean(o * o, axis=-1, keepdims=True) + RMS_EPS) * g
        return o

    out = lax.map(one_block, (jnp.arange(nblk, dtype=jnp.int32), qb))
    return out.swapaxes(0, 1).reshape(B, S, ATTN_V_W).astype(q.dtype)


def short_gated_conv(h, gate_b, gate_c, conv_w):
    u = gate_c * h
    up = jnp.pad(u, ((0, 0), (CONV_K - 1, 0), (0, 0)))
    S = h.shape[1]
    y = conv_w[0] * up[:, 0:S] + conv_w[1] * up[:, 1:S + 1] + conv_w[2] * up[:, 2:S + 2]
    return gate_b * y


def swiglu(h, w_gu, w_down):
    gu = h @ w_gu
    g, u = jnp.split(gu, 2, axis=-1)
    return (jax.nn.silu(g) * u) @ w_down


def moe_swiglu(h, router_w, w_gu, w_down):
    B, S, D = h.shape
    xf = h.reshape(B * S, D)
    logits = (xf @ router_w).astype(jnp.float32)
    top_v, top_i = lax.top_k(logits, TOP_K)
    gates = jax.nn.softmax(top_v, axis=-1)
    cw = jnp.sum(jax.nn.one_hot(top_i, N_EXPERTS, dtype=jnp.float32) * gates[..., None], axis=1)
    cw = cw.astype(h.dtype)
    out = jnp.zeros_like(xf)
    for e in range(N_EXPERTS):
        out = out + cw[:, e:e + 1] * swiglu(xf, w_gu[e], w_down[e])
    return out.reshape(B, S, D)


def setup_inputs(seed: int = 0) -> dict:
    key = jax.random.key(seed)
    ks = jax.random.split(key, 17)
    f32 = jnp.float32
    nrm = lambda k, shape, s: (jax.random.normal(k, shape, f32) * s)
    x = jax.random.normal(ks[0], (BATCH, SEQ, D_MODEL), f32)
    rel_bias = nrm(ks[1], (NUM_BUCKETS, N_HEADS), 0.5)
    mix_norm_g = 1.0 + nrm(ks[2], (DEPTH, D_MODEL), 0.02)
    w_in = nrm(ks[3], (DEPTH, D_MODEL, IN_W), D_MODEL ** -0.5)
    lam_qk = nrm(ks[4], (DEPTH, 4, HEAD_DIM), 0.1)
    subln_g = 1.0 + nrm(ks[5], (DEPTH, V_HEAD_DIM), 0.02)
    conv_w = nrm(ks[6], (DEPTH, CONV_K, CONV_W), CONV_K ** -0.5)
    w_o_attn = nrm(ks[7], (DEPTH, ATTN_V_W, D_MODEL), ATTN_V_W ** -0.5)
    w_o_conv = nrm(ks[8], (DEPTH, CONV_W, D_MODEL), CONV_W ** -0.5)
    w_o = nrm(ks[9], (DEPTH, D_MODEL, D_MODEL), D_MODEL ** -0.5)
    ffn_norm_g = 1.0 + nrm(ks[10], (DEPTH, D_MODEL), 0.02)
    dense_w_gate_up = nrm(ks[11], (N_DENSE_LAYERS, D_MODEL, 2 * FF_DENSE), D_MODEL ** -0.5)
    dense_w_down = nrm(ks[12], (N_DENSE_LAYERS, FF_DENSE, D_MODEL), FF_DENSE ** -0.5)
    router_w = nrm(ks[13], (N_MOE_LAYERS, D_MODEL, N_EXPERTS), D_MODEL ** -0.5)
    expert_w_gate_up = nrm(ks[14], (N_MOE_LAYERS, N_EXPERTS, D_MODEL, 2 * FF_EXPERT), D_MODEL ** -0.5)
    expert_w_down = nrm(ks[15], (N_MOE_LAYERS, N_EXPERTS, FF_EXPERT, D_MODEL), FF_EXPERT ** -0.5)
    final_norm_g = 1.0 + nrm(ks[16], (D_MODEL,), 0.02)
    return {"x": x, "rel_bias": rel_bias, "mix_norm_g": mix_norm_g, "w_in": w_in,
            "lam_qk": lam_qk, "subln_g": subln_g, "conv_w": conv_w,
            "w_o_attn": w_o_attn, "w_o_conv": w_o_conv, "w_o": w_o,
            "ffn_norm_g": ffn_norm_g, "dense_w_gate_up": dense_w_gate_up,
            "dense_w_down": dense_w_down, "router_w": router_w,
            "expert_w_gate_up": expert_w_gate_up, "expert_w_down": expert_w_down,
            "final_norm_g": final_norm_g}


def reference(x, rel_bias, mix_norm_g, w_in, lam_qk, subln_g, conv_w, w_o_attn, w_o_conv, w_o,
              ffn_norm_g, dense_w_gate_up, dense_w_down, router_w, expert_w_gate_up,
              expert_w_down, final_norm_g):
    B, S, D = x.shape
    dists = jnp.arange(S, dtype=jnp.int32)
    bias_dist = rel_bias.astype(jnp.float32)[t5_causal_bucket(dists)].T
    offs = np.cumsum([ATTN_QK_W, ATTN_QK_W, ATTN_V_W, CONV_W, CONV_W, CONV_W, D_MODEL]).tolist()

    for l in range(DEPTH):
        h = rmsnorm(x, mix_norm_g[l])
        z = h @ w_in[l]
        q, k, v, ch, cb, cc, ga, gc = jnp.split(z, offs, axis=-1)
        q = q.reshape(B, S, N_HEADS, 2, HEAD_DIM)
        k = k.reshape(B, S, N_HEADS, 2, HEAD_DIM)
        v = v.reshape(B, S, N_HEADS, V_HEAD_DIM)
        lq = lam_qk[l].astype(jnp.float32)
        lam_init = lambda_init_fn(l)
        lam = jnp.exp(jnp.sum(lq[0] * lq[1])) - jnp.exp(jnp.sum(lq[2] * lq[3])) + lam_init
        a = diff_attention(q, k, v, bias_dist, lam, lam_init, subln_g[l])
        c = short_gated_conv(ch, cb, cc, conv_w[l])
        merged = jax.nn.sigmoid(ga) * (a @ w_o_attn[l]) + jax.nn.sigmoid(gc) * (c @ w_o_conv[l])
        x = x + merged @ w_o[l]
        h = rmsnorm(x, ffn_norm_g[l])
        if l % 2 == 0:
            f = swiglu(h, dense_w_gate_up[l // 2], dense_w_down[l // 2])
        else:
            f = moe_swiglu(h, router_w[l // 2], expert_w_gate_up[l // 2], expert_w_down[l // 2])
        x = x + f

    return rmsnorm(x, final_norm_g)
```

```cpp
#include <hip/hip_runtime.h>
#include <hip/hip_bf16.h>
#include <cstdio>
#include <cstdint>
#include <cmath>

#ifndef MK_N_LAUNCHES
#define MK_N_LAUNCHES 1
#endif

namespace pg8 {
#define PG8_LAS __attribute__((address_space(3)))
typedef unsigned short bf16_t;
typedef short bf16x8 __attribute__((ext_vector_type(8)));
typedef float f32x4 __attribute__((ext_vector_type(4)));
typedef unsigned u32x4 __attribute__((ext_vector_type(4)));
typedef unsigned u32x2 __attribute__((ext_vector_type(2)));
constexpr int BM = 256, BK = 64, HALF = 128, HTB = HALF * BK * 2  , STAGE_BYTES = 8 * HTB, NXCD = 8, WGM = 8;

__host__ __device__ __forceinline__ int lds_byte(int r, int c) { const int st = (r >> 4) * 2 + (c >> 5), rr = r & 15, cc = c & 31, ob = rr * 64 + cc * 2; return st * 1024 + (ob ^ (((ob >> 9) & 1) << 5)); }
__host__ __device__ __forceinline__ void stage_rc(int b, int& R, int& C) { const int st = b / 1024, sb = b % 1024, swz = sb ^ (((sb >> 9) & 1) << 5); R = (st >> 1) * 16 + swz / 64; C = (st & 1) * 32 + (swz % 64) / 2; }
__host__ __device__ __forceinline__ int perm32(int rho) { const int n = rho >> 4, i = rho & 15; return 8 * (i >> 2) + 4 * n + (i & 3); }

struct Unit { int pm, pn, be; };
struct Gemm { const bf16_t* A; const bf16_t* Bt; int M, N, K; };

struct StaticOrder {
    int nM, nN, nwg, G, c;
    __host__ __device__ void init(int M, int N, int G_, int c_) { nM = M / BM; nN = N / BM; nwg = nM * nN; G = G_; c = c_; }
    __host__ __device__ bool next(int i, Unit& u) const {
        const long L = (long)i * G + c; if (L >= nwg) return false;
        int wgid = (int)L; { const int q = nwg / NXCD, r = nwg % NXCD, xcd = wgid % NXCD, off = wgid / NXCD; wgid = (xcd < r ? xcd * (q + 1) : r * (q + 1) + (xcd - r) * q) + off; }
        const int nig = WGM * nN, gid = wgid / nig, fm = gid * WGM, gsz = (nM - fm) < WGM ? (nM - fm) : WGM;
        u.pm = fm + ((wgid % nig) % gsz); u.pn = (wgid % nig) / gsz; u.be = 0; return true;
    }
    __device__ __forceinline__ void a_ready(const Unit&) const {}
    __device__ __forceinline__ void done(const Unit&) const {}
};
struct MoeOrder {
    int nM, nN, nwg, G, c, erows; int ps[8];
    __device__ __forceinline__ void init(int npan, int N, int G_, int c_, int erows_) { nM = npan; nN = N / BM; nwg = nM * nN; G = G_; c = c_; erows = erows_; }
    __device__ __forceinline__ bool next(int i, Unit& u) const {
        const long L = (long)i * G + c; if (L >= nwg) return false;
        int wgid = (int)L; { const int q = nwg / NXCD, r = nwg % NXCD, xcd = wgid % NXCD, off = wgid / NXCD; wgid = (xcd < r ? xcd * (q + 1) : r * (q + 1) + (xcd - r) * q) + off; }
        const int nig = WGM * nN, gid = wgid / nig, fm = gid * WGM, gsz = (nM - fm) < WGM ? (nM - fm) : WGM;
        u.pm = fm + ((wgid % nig) % gsz); u.pn = (wgid % nig) / gsz;
        int e = 0;
#pragma unroll
        for (int k = 1; k < 8; ++k) e += (u.pm >= ps[k]) ? 1 : 0;
        u.be = e * erows; return true;
    }
    __device__ __forceinline__ void a_ready(const Unit&) const {}
    __device__ __forceinline__ void done(const Unit&) const {}
};

__device__ __forceinline__ unsigned cvt_pk_bf16(float lo, float hi) { unsigned r; asm volatile("v_cvt_pk_bf16_f32 %0, %1, %2" : "=v"(r) : "v"(lo), "v"(hi)); return r; }
__device__ __forceinline__ float bf_lo(unsigned w) { return __uint_as_float(w << 16); }
__device__ __forceinline__ float bf_hi(unsigned w) { return __uint_as_float(w & 0xffff0000u); }
__device__ __forceinline__ float sigmoidf_(float x) { return __builtin_amdgcn_rcpf(1.f + __builtin_amdgcn_exp2f(-1.4426950408889634f * x)); }
__device__ __forceinline__ u32x4 pack8(const f32x4 a, const f32x4 b) { u32x4 w; w.x = cvt_pk_bf16(a[0], a[1]); w.y = cvt_pk_bf16(a[2], a[3]); w.z = cvt_pk_bf16(b[0], b[1]); w.w = cvt_pk_bf16(b[2], b[3]); return w; }

struct RowScaleP16 { const float* p;
    __device__ __forceinline__ float get(int row, int fq) const { const f32x4 a = ((const f32x4*)(p + (size_t)row * 16))[fq];
        float s = (a[0] + a[1]) + (a[2] + a[3]); s += __shfl_xor(s, 16); s += __shfl_xor(s, 32);
        return __builtin_amdgcn_rsqf(s * (1.0f / 1024.0f) + 1e-6f); } };
struct RowScaleDirect { const float* rs; __device__ __forceinline__ float get(int row, int) const { return rs[row]; } };

struct EpiInProj {
    static constexpr bool PERM = true, AFTER_DRAIN = false;
    bf16_t* Z; size_t gstride; RowScaleP16 rs;
    __device__ __forceinline__ void operator()(const f32x4 (&acc)[2][2][4][2], const Unit& u, int wr, int wc, int fr, int fq) const {
        const int grp = u.pn >> 2; bf16_t* base = Z + (size_t)grp * gstride; const int col0 = (u.pn & 3) * BM + wc * 32 + 8 * fq, row0 = u.pm * BM + wr * 64 + fr; const bool sig = grp >= 6;
#pragma unroll
        for (int ai = 0; ai < 2; ++ai)
#pragma unroll
            for (int m = 0; m < 4; ++m) { const int row = row0 + ai * HALF + m * 16; const float s = rs.get(row, fq); bf16_t* rowp = base + (size_t)row * 1024 + col0;
#pragma unroll
                for (int bj = 0; bj < 2; ++bj) { f32x4 v0 = acc[ai][bj][m][0] * s, v1 = acc[ai][bj][m][1] * s;
                    if (sig) {
#pragma unroll
                        for (int i = 0; i < 4; ++i) { v0[i] = sigmoidf_(v0[i]); v1[i] = sigmoidf_(v1[i]); } }
                    *(u32x4*)(rowp + bj * HALF) = pack8(v0, v1); } }
    }
};
struct EpiGateA {
    static constexpr bool PERM = true, AFTER_DRAIN = false;
    bf16_t* G;
    __device__ __forceinline__ void operator()(const f32x4 (&acc)[2][2][4][2], const Unit& u, int wr, int wc, int fr, int fq) const {
        const int col0 = u.pn * BM + wc * 32 + 8 * fq, row0 = u.pm * BM + wr * 64 + fr;
#pragma unroll
        for (int ai = 0; ai < 2; ++ai)
#pragma unroll
            for (int m = 0; m < 4; ++m) { bf16_t* rowp = G + (size_t)(row0 + ai * HALF + m * 16) * 1024 + col0;
#pragma unroll
                for (int bj = 0; bj < 2; ++bj) { const u32x4 g = *(const u32x4*)(rowp + bj * HALF); const f32x4 a0 = acc[ai][bj][m][0], a1 = acc[ai][bj][m][1];
                    const f32x4 v0 = {bf_lo(g.x) * a0[0], bf_hi(g.x) * a0[1], bf_lo(g.y) * a0[2], bf_hi(g.y) * a0[3]}, v1 = {bf_lo(g.z) * a1[0], bf_hi(g.z) * a1[1], bf_lo(g.w) * a1[2], bf_hi(g.w) * a1[3]};
                    *(u32x4*)(rowp + bj * HALF) = pack8(v0, v1); } }
    }
};
struct EpiGateB {
    static constexpr bool PERM = true, AFTER_DRAIN = false;
    bf16_t* P; const bf16_t* Gc;
    __device__ __forceinline__ void operator()(const f32x4 (&acc)[2][2][4][2], const Unit& u, int wr, int wc, int fr, int fq) const {
        const int col0 = u.pn * BM + wc * 32 + 8 * fq, row0 = u.pm * BM + wr * 64 + fr;
#pragma unroll
        for (int ai = 0; ai < 2; ++ai)
#pragma unroll
            for (int m = 0; m < 4; ++m) { const size_t off = (size_t)(row0 + ai * HALF + m * 16) * 1024 + col0;
#pragma unroll
                for (int bj = 0; bj < 2; ++bj) { const u32x4 p = *(const u32x4*)(P + off + bj * HALF), g = *(const u32x4*)(Gc + off + bj * HALF); const f32x4 a0 = acc[ai][bj][m][0], a1 = acc[ai][bj][m][1];
                    const f32x4 v0 = {bf_lo(p.x) + bf_lo(g.x) * a0[0], bf_hi(p.x) + bf_hi(g.x) * a0[1], bf_lo(p.y) + bf_lo(g.y) * a0[2], bf_hi(p.y) + bf_hi(g.y) * a0[3]};
                    const f32x4 v1 = {bf_lo(p.z) + bf_lo(g.z) * a1[0], bf_hi(p.z) + bf_hi(g.z) * a1[1], bf_lo(p.w) + bf_lo(g.w) * a1[2], bf_hi(p.w) + bf_hi(g.w) * a1[3]};
                    *(u32x4*)(P + off + bj * HALF) = pack8(v0, v1); } }
    }
};
struct EpiResid {
    static constexpr bool PERM = false, AFTER_DRAIN = false;
    const float* xin; float* xout; bf16_t* xb; float* ssqp;
    __device__ __forceinline__ void operator()(const f32x4 (&acc)[2][2][4][2], const Unit& u, int wr, int wc, int fr, int fq) const {
        const int col0 = u.pn * BM + wc * 32 + 4 * fq, row0 = u.pm * BM + wr * 64 + fr;
#pragma unroll
        for (int ai = 0; ai < 2; ++ai)
#pragma unroll
            for (int m = 0; m < 4; ++m) { const int row = row0 + ai * HALF + m * 16; const size_t off = (size_t)row * 1024 + col0; float ss = 0.f;
#pragma unroll
                for (int bj = 0; bj < 2; ++bj)
#pragma unroll
                    for (int n = 0; n < 2; ++n) { const size_t o = off + bj * HALF + n * 16; const f32x4 v = *(const f32x4*)(xin + o) + acc[ai][bj][m][n]; *(f32x4*)(xout + o) = v;
                        ss += (v[0] * v[0] + v[1] * v[1]) + (v[2] * v[2] + v[3] * v[3]); u32x2 w; w.x = cvt_pk_bf16(v[0], v[1]); w.y = cvt_pk_bf16(v[2], v[3]); *(u32x2*)(xb + o) = w; }
                ss += __shfl_xor(ss, 16); ss += __shfl_xor(ss, 32);
                if (fq == 0) ssqp[(size_t)row * 16 + u.pn * 4 + wc] = ss; }
    }
};
template <class RS> struct EpiSwiGLU {
    static constexpr bool PERM = true, AFTER_DRAIN = false;
    bf16_t* H; int ldh; RS rs;
    __device__ __forceinline__ void operator()(const f32x4 (&acc)[2][2][4][2], const Unit& u, int wr, int wc, int fr, int fq) const {
        const int col0 = u.pn * HALF + wc * 32 + 8 * fq, row0 = u.pm * BM + wr * 64 + fr;
#pragma unroll
        for (int ai = 0; ai < 2; ++ai)
#pragma unroll
            for (int m = 0; m < 4; ++m) { const int row = row0 + ai * HALF + m * 16; const float s = rs.get(row, fq); f32x4 h[2];
#pragma unroll
                for (int n = 0; n < 2; ++n) { const f32x4 g = acc[ai][0][m][n] * s, uu = acc[ai][1][m][n] * s;
#pragma unroll
                    for (int i = 0; i < 4; ++i) h[n][i] = g[i] * uu[i] * sigmoidf_(g[i]); }
                *(u32x4*)(H + (size_t)row * ldh + col0) = pack8(h[0], h[1]); }
    }
};
struct EpiPlainBf16 {
    static constexpr bool PERM = true, AFTER_DRAIN = false;
    bf16_t* O; int ldc;
    __device__ __forceinline__ void operator()(const f32x4 (&acc)[2][2][4][2], const Unit& u, int wr, int wc, int fr, int fq) const {
        const int col0 = u.pn * BM + wc * 32 + 8 * fq, row0 = u.pm * BM + wr * 64 + fr;
#pragma unroll
        for (int ai = 0; ai < 2; ++ai)
#pragma unroll
            for (int m = 0; m < 4; ++m) { bf16_t* rowp = O + (size_t)(row0 + ai * HALF + m * 16) * ldc + col0;
#pragma unroll
                for (int bj = 0; bj < 2; ++bj) *(u32x4*)(rowp + bj * HALF) = pack8(acc[ai][bj][m][0], acc[ai][bj][m][1]); }
    }
};

template <class Epi, class Sched, bool ALIGN_EPI = false, bool SP2 = false>
__device__ __forceinline__ void gemm_phase(PG8_LAS unsigned char* lds, const Gemm g, const Sched& S, const Epi& E) {
    int tid_ = threadIdx.x; asm volatile("" : "+v"(tid_));
    const int tid = tid_, wid = __builtin_amdgcn_readfirstlane(tid >> 6), lane = tid & 63, wr = wid >> 2, wc = wid & 3, fr = lane & 15, fq = lane >> 4;
    const int K = g.K, nt = K / BK;
    unsigned voffA[2], voffB[2];
#pragma unroll
    for (int i = 0; i < 2; ++i) { int R, C; stage_rc(tid * 16 + i * 8192, R, C); const int Rb = Epi::PERM ? ((R & ~31) + perm32(R & 31)) : R;
        voffA[i] = (unsigned)(R * K + C) * 2u; voffB[i] = (unsigned)(Rb * K + C) * 2u; }
    const size_t kstep = (size_t)(BK * 2);
    const size_t hstep = (size_t)HALF * K * 2;
    const size_t tstep = 2 * hstep; const size_t rstep = (size_t)K * 2;
    const unsigned ldsw = (unsigned)wid * 1024u;
    const int aoff = lds_byte(wr * 64 + fr, fq * 8), boff = lds_byte(wc * 32 + fr, fq * 8);
#define PG8_SA(b, h) (((b) * 2 + (h)) * HTB)
#define PG8_SB(b, h) ((4 + (b) * 2 + (h)) * HTB)
#define PG8_STAGE(bufoff, gbase, voff) do { _Pragma("unroll") for (int _i = 0; _i < 2; ++_i) \
        __builtin_amdgcn_global_load_lds((const unsigned*)((const char*)(gbase) + (voff)[_i]), (PG8_LAS unsigned*)(lds + (bufoff) + ldsw + _i * 8192), 16, 0, 0); } while (0)
#define PG8_LDA(dst, b, h) do { _Pragma("unroll") for (int m = 0; m < 4; ++m) _Pragma("unroll") for (int k = 0; k < 2; ++k) dst[m][k] = *(const PG8_LAS bf16x8*)(lds + PG8_SA(b, h) + aoff + m * 2048 + k * 1024); } while (0)
#define PG8_LDB(dst, b, h) do { _Pragma("unroll") for (int n = 0; n < 2; ++n) _Pragma("unroll") for (int k = 0; k < 2; ++k) dst[n][k] = *(const PG8_LAS bf16x8*)(lds + PG8_SB(b, h) + boff + n * 2048 + k * 1024); } while (0)
#define PG8_MMA(ai, bj, At, Bt) do { __builtin_amdgcn_s_setprio(1); _Pragma("unroll") for (int m = 0; m < 4; ++m) _Pragma("unroll") for (int n = 0; n < 2; ++n) _Pragma("unroll") for (int k = 0; k < 2; ++k) \
        acc[ai][bj][m][n] = __builtin_amdgcn_mfma_f32_16x16x32_bf16(Bt[n][k], At[m][k], acc[ai][bj][m][n], 0, 0, 0); __builtin_amdgcn_s_setprio(0); } while (0)
#define PG8_WAIT_V(n) asm volatile("s_waitcnt vmcnt(" #n ")" ::: "memory")
#define PG8_WAIT_L(n) asm volatile("s_waitcnt lgkmcnt(" #n ")" ::: "memory")
#define PG8_BAR __builtin_amdgcn_s_barrier()
#define PG8_SCHED __builtin_amdgcn_sched_barrier(0)
    Unit cur, nxt; int ui = 0;
    if (!S.next(0, cur)) return;
    f32x4 acc[2][2][4][2];
#pragma unroll
    for (int a = 0; a < 2; ++a)
#pragma unroll
        for (int b = 0; b < 2; ++b)
#pragma unroll
            for (int m = 0; m < 4; ++m)
#pragma unroll
                for (int n = 0; n < 2; ++n) acc[a][b][m][n] = (f32x4){0.f, 0.f, 0.f, 0.f};
    bf16x8 At[4][2], B0[2][2], B1[2][2];
    const char* cA = (const char*)g.A + (size_t)cur.pm * tstep; const char* cB = (const char*)g.Bt + (size_t)cur.pn * tstep + (size_t)cur.be * rstep;
    S.a_ready(cur);
    if constexpr (SP2) {
        PG8_STAGE(PG8_SB(0, 0), cB, voffB); PG8_STAGE(PG8_SB(0, 1), cB + hstep, voffB); PG8_STAGE(PG8_SA(0, 0), cA, voffA); PG8_STAGE(PG8_SA(0, 1), cA + hstep, voffA);
        if (wr == 1) PG8_BAR;
        PG8_WAIT_V(2); PG8_BAR;
        PG8_STAGE(PG8_SB(1, 0), cB + kstep, voffB); PG8_STAGE(PG8_SA(1, 0), cA + kstep, voffA); PG8_STAGE(PG8_SB(1, 1), cB + hstep + kstep, voffB);
        PG8_WAIT_V(6); PG8_BAR;
    } else {
        PG8_STAGE(PG8_SB(0, 0), cB, voffB); PG8_STAGE(PG8_SA(0, 0), cA, voffA); PG8_STAGE(PG8_SB(0, 1), cB + hstep, voffB); PG8_STAGE(PG8_SA(0, 1), cA + hstep, voffA);
        if (wr == 1) PG8_BAR;
        PG8_WAIT_V(4); PG8_BAR;
        PG8_STAGE(PG8_SB(1, 0), cB + kstep, voffB); PG8_STAGE(PG8_SA(1, 0), cA + kstep, voffA); PG8_STAGE(PG8_SB(1, 1), cB + hstep + kstep, voffB);
        PG8_WAIT_V(6); PG8_BAR;
    }
    for (;;) {
        const bool has_next = S.next(ui + 1, nxt);
        const char* nA = has_next ? (const char*)g.A + (size_t)nxt.pm * tstep : cA; const char* nB = has_next ? (const char*)g.Bt + (size_t)nxt.pn * tstep + (size_t)nxt.be * rstep : cB;
        for (int t = 0; t < nt; t += 2) {
            const bool last = (t == nt - 2);
            const char* a1 = cA + (size_t)(t + 1) * kstep;
            const char* a2 = last ? nA : cA + (size_t)(t + 2) * kstep; const char* b2 = last ? nB : cB + (size_t)(t + 2) * kstep;
            const char* a3 = a2 + kstep; const char* b3 = b2 + kstep;
            if (last && has_next) S.a_ready(nxt);
            if constexpr (SP2) {
            PG8_LDB(B0, 0, 0); PG8_LDB(B1, 0, 1); PG8_SCHED; PG8_LDA(At, 0, 0); PG8_STAGE(PG8_SA(1, 1), a1 + hstep, voffA);
            PG8_WAIT_V(8); PG8_WAIT_L(0); PG8_BAR; PG8_MMA(0, 0, At, B0); PG8_MMA(0, 1, At, B1); PG8_BAR; PG8_SCHED;
            PG8_LDA(At, 0, 1); PG8_STAGE(PG8_SB(0, 0), b2, voffB); PG8_STAGE(PG8_SB(0, 1), b2 + hstep, voffB); PG8_STAGE(PG8_SA(0, 0), a2, voffA);
            PG8_WAIT_V(8); PG8_WAIT_L(0); PG8_BAR; PG8_MMA(1, 0, At, B0); PG8_MMA(1, 1, At, B1); PG8_BAR; PG8_SCHED;
            PG8_LDB(B0, 1, 0); PG8_LDB(B1, 1, 1); PG8_SCHED; PG8_LDA(At, 1, 0); PG8_STAGE(PG8_SA(0, 1), a2 + hstep, voffA);
            PG8_WAIT_V(8); PG8_WAIT_L(0); PG8_BAR; PG8_MMA(0, 0, At, B0); PG8_MMA(0, 1, At, B1); PG8_BAR; PG8_SCHED;
            PG8_LDA(At, 1, 1); PG8_STAGE(PG8_SB(1, 0), b3, voffB); PG8_STAGE(PG8_SB(1, 1), b3 + hstep, voffB); PG8_STAGE(PG8_SA(1, 0), a3, voffA);
            PG8_WAIT_V(8); PG8_WAIT_L(0); PG8_BAR; PG8_MMA(1, 0, At, B0); PG8_MMA(1, 1, At, B1); PG8_BAR; PG8_SCHED;
            } else {
            PG8_LDB(B0, 0, 0); PG8_SCHED; PG8_LDA(At, 0, 0); PG8_STAGE(PG8_SA(1, 1), a1 + hstep, voffA);
            PG8_WAIT_L(8); PG8_BAR; PG8_WAIT_L(0); PG8_MMA(0, 0, At, B0); PG8_BAR; PG8_SCHED;
            PG8_LDB(B1, 0, 1); PG8_STAGE(PG8_SB(0, 0), b2, voffB);
            PG8_BAR; PG8_WAIT_L(0); PG8_MMA(0, 1, At, B1); PG8_BAR;
            PG8_LDA(At, 0, 1); PG8_STAGE(PG8_SA(0, 0), a2, voffA);
            PG8_BAR; PG8_WAIT_L(0); PG8_MMA(1, 0, At, B0); PG8_BAR; PG8_SCHED;
            PG8_STAGE(PG8_SB(0, 1), b2 + hstep, voffB);
            PG8_WAIT_V(6); PG8_BAR; PG8_MMA(1, 1, At, B1); PG8_BAR;
            PG8_LDB(B0, 1, 0); PG8_SCHED; PG8_LDA(At, 1, 0); PG8_STAGE(PG8_SA(0, 1), a2 + hstep, voffA);
            PG8_WAIT_L(8); PG8_BAR; PG8_WAIT_L(0); PG8_MMA(0, 0, At, B0); PG8_BAR; PG8_SCHED;
            PG8_LDB(B1, 1, 1); PG8_STAGE(PG8_SB(1, 0), b3, voffB);
            PG8_BAR; PG8_WAIT_L(0); PG8_MMA(0, 1, At, B1); PG8_BAR;
            PG8_LDA(At, 1, 1); PG8_STAGE(PG8_SA(1, 0), a3, voffA);
            PG8_BAR; PG8_WAIT_L(0); PG8_MMA(1, 0, At, B0); PG8_BAR; PG8_SCHED;
            PG8_STAGE(PG8_SB(1, 1), b3 + hstep, voffB);
            PG8_WAIT_V(6); PG8_BAR; PG8_MMA(1, 1, At, B1); PG8_BAR;
            }
        }
        if constexpr (ALIGN_EPI) { if (wr == 0) PG8_BAR; }
        if constexpr (!Epi::AFTER_DRAIN) { E(acc, cur, wr, wc, fr, fq); S.done(cur); }
        if (!has_next) break;
#pragma unroll
        for (int a = 0; a < 2; ++a)
#pragma unroll
            for (int b = 0; b < 2; ++b)
#pragma unroll
                for (int m = 0; m < 4; ++m)
#pragma unroll
                    for (int n = 0; n < 2; ++n) acc[a][b][m][n] = (f32x4){0.f, 0.f, 0.f, 0.f};
        cur = nxt; cA = nA; cB = nB; ++ui;
        if constexpr (ALIGN_EPI) { if (wr == 1) PG8_BAR; }
    }
    PG8_WAIT_V(0);
    if constexpr (!ALIGN_EPI) { if (wr == 0) PG8_BAR; }
    PG8_BAR;
    if constexpr (Epi::AFTER_DRAIN) { E.fused(acc, cur, wr, wc, fr, fq, lds, wid, lane); S.done(cur); }
#undef PG8_SA
#undef PG8_SB
#undef PG8_STAGE
#undef PG8_LDA
#undef PG8_LDB
#undef PG8_MMA
#undef PG8_WAIT_V
#undef PG8_WAIT_L
#undef PG8_BAR
#undef PG8_SCHED
}
}

namespace dattn {
using bf16 = unsigned short;
using bf16x8 = __attribute__((ext_vector_type(8))) short;
using s16x4 = __attribute__((ext_vector_type(4))) short;
using f32x16 = __attribute__((ext_vector_type(16))) float;
using f32x4 = __attribute__((ext_vector_type(4))) float;
using u32x4 = __attribute__((ext_vector_type(4))) unsigned;
constexpr int SEQ = 16384, PITCH = 1024, KVBLK = 64, QBLK = 32, UROWS = 128;
constexpr int SHM_V = KVBLK * 128 * 2, SHM_K = KVBLK * 128 * 2;
constexpr int XPITCH = 132;
constexpr int L_V = 0, L_K = 2 * SHM_V, L_XCH = 0, XCH_WAVE = 32 * XPITCH * 4, L_WS = 4 * XCH_WAVE, L_TAB = L_WS + 8 * 256, LDS_BYTES = L_TAB + 384 * 4;
static_assert(L_WS >= 2 * SHM_V + 2 * SHM_K, "exchange region overlays the K/V buffers");
constexpr float LOG2E = 1.4426950408889634f;
constexpr float THR = 8.f;
__constant__ unsigned char BKT[128] = {0, 1, 2, 3, 4, 5, 6, 7, 8, 9, 10, 11, 12, 13, 14, 15, 16, 16, 16, 17, 17, 18, 18, 18, 19, 19, 19, 20, 20, 20, 20, 21, 21, 21, 21, 22, 22, 22, 22, 22, 23, 23, 23, 23, 23, 23, 24, 24, 24, 24, 24, 24,
    25, 25, 25, 25, 25, 25, 25, 26, 26, 26, 26, 26, 26, 26, 26, 27, 27, 27, 27, 27, 27, 27, 27, 27, 27, 28, 28, 28, 28, 28, 28, 28, 28, 28, 28, 29, 29, 29, 29, 29, 29, 29, 29, 29, 29, 29, 29,
    30, 30, 30, 30, 30, 30, 30, 30, 30, 30, 30, 30, 30, 30, 31, 31, 31, 31, 31, 31, 31, 31, 31, 31, 31, 31, 31, 31, 31};
#define KSWZ(row, colB) ((row) * 256 + ((colB) ^ (((row) & 7) << 4)))
#define SBAR() __builtin_amdgcn_sched_barrier(0)
__device__ __forceinline__ int crow(int r, int hi) { return (r & 3) + 8 * (r >> 2) + 4 * hi; }
__device__ __forceinline__ unsigned cvtpk(float lo, float hi) { unsigned r; asm volatile("v_cvt_pk_bf16_f32 %0, %1, %2" : "=v"(r) : "v"(lo), "v"(hi)); return r; }

__device__ __forceinline__ void partialSM(f32x16& p0, f32x16& p1, float& m_reg, float& alpha, bool band, const float* tl) {
  if (band) {
#pragma unroll
    for (int r = 0; r < 16; ++r) { const int c = (r & 3) + 8 * (r >> 2); p0[r] += tl[c]; p1[r] += tl[32 + c]; }
  }
  float pmax = p0[0];
#pragma unroll
  for (int r = 1; r < 16; ++r) pmax = fmaxf(pmax, p0[r]);
#pragma unroll
  for (int r = 0; r < 16; ++r) pmax = fmaxf(pmax, p1[r]);
  { auto rr = __builtin_amdgcn_permlane32_swap(__float_as_uint(pmax), __float_as_uint(pmax), false, false);
    pmax = fmaxf(__uint_as_float(rr[0]), __uint_as_float(rr[1])); }
  float mn;
  if (__builtin_expect(__all(pmax - m_reg <= THR), 1)) { mn = m_reg; alpha = 1.f; }
  else { mn = fmaxf(m_reg, pmax); alpha = __builtin_amdgcn_exp2f(m_reg - mn); m_reg = mn; }
#pragma unroll
  for (int r = 0; r < 16; ++r) { p0[r] -= mn; p1[r] -= mn; }
#pragma unroll
  for (int r = 0; r < 16; ++r) p0[r] = __builtin_amdgcn_exp2f(p0[r]);
}
__device__ __forceinline__ void finishSM(f32x16& p0, f32x16& p1, float alpha, float& l_reg, bf16x8& pa0, bf16x8& pa1, bf16x8& pa2, bf16x8& pa3) {
#pragma unroll
  for (int r = 0; r < 16; ++r) p1[r] = __builtin_amdgcn_exp2f(p1[r]);
  float ps = 0;
#pragma unroll
  for (int r = 0; r < 16; ++r) ps += p0[r];
#pragma unroll
  for (int r = 0; r < 16; ++r) ps += p1[r];
  { auto rr = __builtin_amdgcn_permlane32_swap(__float_as_uint(ps), __float_as_uint(ps), false, false);
    ps = __uint_as_float(rr[0]) + __uint_as_float(rr[1]); }
  l_reg = l_reg * alpha + ps;
#define PK4(P, BASE, OUT) do { unsigned a0 = cvtpk(P[BASE + 0], P[BASE + 1]), a1 = cvtpk(P[BASE + 2], P[BASE + 3]);   \
    unsigned b0 = cvtpk(P[BASE + 4], P[BASE + 5]), b1 = cvtpk(P[BASE + 6], P[BASE + 7]);                              \
    auto r0 = __builtin_amdgcn_permlane32_swap(a0, b0, false, false); auto r1 = __builtin_amdgcn_permlane32_swap(a1, b1, false, false); \
    u32x4 w = {r0[0], r1[0], r0[1], r1[1]}; OUT = *reinterpret_cast<bf16x8*>(&w); } while (0)
  PK4(p0, 0, pa0); PK4(p0, 8, pa1); PK4(p1, 0, pa2); PK4(p1, 8, pa3);
#undef PK4
}
__device__ __forceinline__ void qkt(f32x16& p0, f32x16& p1, const char* Ks, const bf16x8* qr, int r32, int hi, int map) {
  p0 = f32x16{}; p1 = f32x16{};
#pragma unroll
  for (int d0 = 0; d0 < 4; ++d0) { const int cb = (map * 64 + d0 * 16 + hi * 8) * 2;
    const bf16x8 b0 = *reinterpret_cast<const bf16x8*>(Ks + KSWZ(r32, cb));
    const bf16x8 b1 = *reinterpret_cast<const bf16x8*>(Ks + KSWZ(32 + r32, cb));
    p0 = __builtin_amdgcn_mfma_f32_32x32x16_bf16(b0, qr[d0], p0, 0, 0, 0);
    p1 = __builtin_amdgcn_mfma_f32_32x32x16_bf16(b1, qr[d0], p1, 0, 0, 0); }
}
__device__ __forceinline__ int v_st(int k, int c) { const int kk = (k & ~0xC) | ((k & 4) << 1) | ((k & 8) >> 1); return ((kk >> 3) * 4 + (c >> 5)) * 512 + ((kk & 7) * 32 + (c & 31)) * 2; }
__device__ __forceinline__ int v_rd_base(int lane) { return ((lane & 3) << 3) | (((lane >> 2) & 3) << 6) | (((lane >> 4) & 1) << 5) | (((lane >> 5) & 1) << 8); }
constexpr int v_rd_off(int d0, int ks, int half) { return d0 * 512 + ks * 4096 + half * 2048; }
template <int OFF> __device__ __forceinline__ s16x4 tr_read(int vb) {
  s16x4 r; asm volatile("ds_read_b64_tr_b16 %0, %1 offset:%2" : "=&v"(r) : "v"(vb), "i"(OFF) : "memory"); return r;
}
template <int D0> __device__ __forceinline__ void pv_one(f32x16& od, int vb, bf16x8 pa0, bf16x8 pa1, bf16x8 pa2, bf16x8 pa3) {
  const s16x4 l0 = tr_read<v_rd_off(D0, 0, 0)>(vb), h0 = tr_read<v_rd_off(D0, 0, 1)>(vb), l1 = tr_read<v_rd_off(D0, 1, 0)>(vb), h1 = tr_read<v_rd_off(D0, 1, 1)>(vb);
  const s16x4 l2 = tr_read<v_rd_off(D0, 2, 0)>(vb), h2 = tr_read<v_rd_off(D0, 2, 1)>(vb), l3 = tr_read<v_rd_off(D0, 3, 0)>(vb), h3 = tr_read<v_rd_off(D0, 3, 1)>(vb);
  asm volatile("s_waitcnt lgkmcnt(0)" ::: "memory"); SBAR();
#define PK(L, H) (bf16x8){L[0], L[1], L[2], L[3], H[0], H[1], H[2], H[3]}
  od = __builtin_amdgcn_mfma_f32_32x32x16_bf16(pa0, PK(l0, h0), od, 0, 0, 0);
  od = __builtin_amdgcn_mfma_f32_32x32x16_bf16(pa1, PK(l1, h1), od, 0, 0, 0);
  od = __builtin_amdgcn_mfma_f32_32x32x16_bf16(pa2, PK(l2, h2), od, 0, 0, 0);
  od = __builtin_amdgcn_mfma_f32_32x32x16_bf16(pa3, PK(l3, h3), od, 0, 0, 0);
#undef PK
}
__device__ __forceinline__ void pv_d0(f32x16* o, int vb, bf16x8 pa0, bf16x8 pa1, bf16x8 pa2, bf16x8 pa3) {
  pv_one<0>(o[0], vb, pa0, pa1, pa2, pa3); pv_one<1>(o[1], vb, pa0, pa1, pa2, pa3); pv_one<2>(o[2], vb, pa0, pa1, pa2, pa3); pv_one<3>(o[3], vb, pa0, pa1, pa2, pa3);
}

__device__ __forceinline__ void attn_unit(int b, int h, int qb, const bf16* Zq, const bf16* __restrict__ Zk, const bf16* __restrict__ Zv, bf16* Oa,
                                          const float* __restrict__ rel_bias, float lam, const float* __restrict__ gsub, float gmul, char* lds) {
  int tid_ = threadIdx.x; asm volatile("" : "+v"(tid_));
  const int tid = tid_, lane = tid & 63, r32 = lane & 31, hi = lane >> 5; const int wid = __builtin_amdgcn_readfirstlane(tid >> 6);
  const int map = wid >> 2, g = wid & 3;
  const long rowbase = (long)b * SEQ; const int q0 = qb * UROWS, NT = 2 * qb + 2;
  char* V_lds = lds + L_V; char* K_lds = lds + L_K;
  float* ws = (float*)(lds + L_WS) + wid * 64; float* li_l = ws; float* al_l = ws + 32;
  float* tab = (float*)(lds + L_TAB);
  __syncthreads();
  for (int i = tid; i < 384; i += 512) { const int dist = 255 - i; float v;
    if (dist < 0) v = -INFINITY; else if (dist >= 113) v = 0.f; else v = (rel_bias[(int)BKT[dist] * 8 + h] - rel_bias[31 * 8 + h]) * LOG2E;
    tab[i] = v; }
  float m_reg = -1e30f, l_reg = 0.f; f32x16 o[4] = {}; bf16x8 qr[4];
  const bf16* Qw = Zq + (rowbase + q0 + g * QBLK + r32) * PITCH + h * 128 + map * 64 + hi * 8;
#pragma unroll
  for (int d0 = 0; d0 < 4; ++d0) qr[d0] = *reinterpret_cast<const bf16x8*>(Qw + d0 * 16);
  const bf16* Kh = Zk + rowbase * PITCH + h * 128; const bf16* Vh = Zv + rowbase * PITCH + h * 128;
  const int sr = tid >> 4, sc = (tid & 15) * 8, vst0 = v_st(sr, sc), vst1 = v_st(32 + sr, sc);
  const int vb0 = (int)(uintptr_t)V_lds + v_rd_base(lane);
  const int qpos = q0 + g * QBLK + r32;
  const float* tl0 = tab + (255 - qpos + 4 * hi);
  struct { bf16x8 vs0, vs1, ks0, ks1; } sr_[2];
#define SLOAD(i, k0) do { sr_[i].vs0 = *reinterpret_cast<const bf16x8*>(&Vh[(long)((k0) + sr) * PITCH + sc]); sr_[i].vs1 = *reinterpret_cast<const bf16x8*>(&Vh[(long)((k0) + 32 + sr) * PITCH + sc]); \
    sr_[i].ks0 = *reinterpret_cast<const bf16x8*>(&Kh[(long)((k0) + sr) * PITCH + sc]); sr_[i].ks1 = *reinterpret_cast<const bf16x8*>(&Kh[(long)((k0) + 32 + sr) * PITCH + sc]); } while (0)
#define SWRITE(bb, i) do { *(bf16x8*)(V_lds + (bb) * SHM_V + vst0) = sr_[i].vs0; *(bf16x8*)(V_lds + (bb) * SHM_V + vst1) = sr_[i].vs1; const int kc = sc * 2; \
    *(bf16x8*)(K_lds + (bb) * SHM_K + KSWZ(sr, kc)) = sr_[i].ks0; *(bf16x8*)(K_lds + (bb) * SHM_K + KSWZ(32 + sr, kc)) = sr_[i].ks1; } while (0)
#define SWAIT() asm volatile("s_waitcnt vmcnt(4)" ::: "memory")
#define RESC(a) do { if (__any((a) < 1.f)) { if (hi == 0) al_l[r32] = (a); asm volatile("s_waitcnt lgkmcnt(0)" ::: "memory"); \
    _Pragma("unroll") for (int d = 0; d < 4; ++d) _Pragma("unroll") for (int r = 0; r < 16; ++r) o[d][r] *= al_l[crow(r, hi)]; } } while (0)
#define BAND(j) ((j) >= NT - 4)
  f32x16 pA0, pA1, pB0, pB1; float alA, alB; bf16x8 pa0, pa1, pa2, pa3;
  constexpr int SE = 0, SO = 1;
  SLOAD(SE, 0); asm volatile("s_waitcnt vmcnt(0)" ::: "memory"); SWRITE(0, SE); __syncthreads();
  qkt(pA0, pA1, K_lds, qr, r32, hi, map); partialSM(pA0, pA1, m_reg, alA, BAND(0), tl0);
  SLOAD(SO, KVBLK); if (2 < NT) SLOAD(SE, 2 * KVBLK);
  SWAIT(); SWRITE(1, SO); __syncthreads();
  for (int j = 1; j + 1 < NT; j += 2) {
    SBAR(); qkt(pB0, pB1, K_lds + SHM_K, qr, r32, hi, map);
    finishSM(pA0, pA1, alA, l_reg, pa0, pa1, pa2, pa3); SBAR();
    SLOAD(SO, (j + 2) * KVBLK); SBAR();
    pv_d0(o, vb0, pa0, pa1, pa2, pa3); partialSM(pB0, pB1, m_reg, alB, BAND(j), tl0 + j * KVBLK);
    __syncthreads(); SWAIT(); SWRITE(0, SE);
    RESC(alB); __syncthreads();
    SBAR(); qkt(pA0, pA1, K_lds, qr, r32, hi, map);
    finishSM(pB0, pB1, alB, l_reg, pa0, pa1, pa2, pa3); SBAR();
    if (j + 3 < NT) SLOAD(SE, (j + 3) * KVBLK); SBAR();
    pv_d0(o, vb0 + SHM_V, pa0, pa1, pa2, pa3); partialSM(pA0, pA1, m_reg, alA, BAND(j + 1), tl0 + (j + 1) * KVBLK);
    __syncthreads(); SWAIT(); SWRITE(1, SO);
    RESC(alA); __syncthreads();
  }
  SBAR(); qkt(pB0, pB1, K_lds + SHM_K, qr, r32, hi, map);
  finishSM(pA0, pA1, alA, l_reg, pa0, pa1, pa2, pa3); SBAR();
  pv_d0(o, vb0, pa0, pa1, pa2, pa3); partialSM(pB0, pB1, m_reg, alB, true, tl0 + (NT - 1) * KVBLK);
  __syncthreads(); RESC(alB);
  finishSM(pB0, pB1, alB, l_reg, pa0, pa1, pa2, pa3); SBAR();
  pv_d0(o, vb0 + SHM_V, pa0, pa1, pa2, pa3);
  if (hi == 0) li_l[r32] = l_reg; asm volatile("s_waitcnt lgkmcnt(0)" ::: "memory");
  float rli[16];
#pragma unroll
  for (int r = 0; r < 16; ++r) rli[r] = __builtin_amdgcn_rcpf(li_l[crow(r, hi)]);
  float* X = (float*)(lds + L_XCH + g * XCH_WAVE);
  __syncthreads();
  if (map == 1) {
#pragma unroll
    for (int d0 = 0; d0 < 4; ++d0)
#pragma unroll
      for (int r = 0; r < 16; ++r) X[crow(r, hi) * XPITCH + d0 * 32 + r32] = o[d0][r] * rli[r];
  }
  __syncthreads();
  if (map == 0) {
#pragma unroll
    for (int d0 = 0; d0 < 4; ++d0)
#pragma unroll
      for (int r = 0; r < 16; ++r) { float* xp = &X[crow(r, hi) * XPITCH + d0 * 32 + r32]; *xp = o[d0][r] * rli[r] - lam * (*xp); }
    asm volatile("s_waitcnt lgkmcnt(0)" ::: "memory");
    const f32x4* xr = (const f32x4*)(X + r32 * XPITCH + hi * 64);
    f32x4 v[16]; float ss = 0.f;
#pragma unroll
    for (int i = 0; i < 16; ++i) { v[i] = xr[i]; ss += (v[i][0] * v[i][0] + v[i][1] * v[i][1]) + (v[i][2] * v[i][2] + v[i][3] * v[i][3]); }
    { auto rr = __builtin_amdgcn_permlane32_swap(__float_as_uint(ss), __float_as_uint(ss), false, false); ss = __uint_as_float(rr[0]) + __uint_as_float(rr[1]); }
    const float rs = __builtin_amdgcn_rsqf(ss * (1.0f / 128.0f) + 1e-6f) * gmul;
    bf16* op = Oa + (rowbase + q0 + g * QBLK + r32) * PITCH + h * 128 + hi * 64;
    const f32x4* gp = (const f32x4*)(gsub + hi * 64);
#pragma unroll
    for (int i = 0; i < 16; i += 2) { const f32x4 g0 = gp[i], g1 = gp[i + 1]; u32x4 w;
      w.x = cvtpk(v[i][0] * rs * g0[0], v[i][1] * rs * g0[1]); w.y = cvtpk(v[i][2] * rs * g0[2], v[i][3] * rs * g0[3]);
      w.z = cvtpk(v[i + 1][0] * rs * g1[0], v[i + 1][1] * rs * g1[1]); w.w = cvtpk(v[i + 1][2] * rs * g1[2], v[i + 1][3] * rs * g1[3]);
      *(u32x4*)(op + i * 4) = w; }
  }
#undef SLOAD
#undef SWRITE
#undef SWAIT
#undef RESC
#undef BAND
}
#undef SBAR
}

constexpr int NWAVES = 8;
constexpr int BATCH = 2, SEQ = 16384, D = 1024, M = BATCH * SEQ, NHEAD = 8, INW = 8192, FFD = 2816, NEXP = 8, FFE = 3584;
constexpr float RMS_EPS = 1e-6f;
constexpr float C2 = 0.125f * 1.4426950408889634f;
constexpr int SLOTS = 2 * M + NEXP * 256;

constexpr size_t MiB = 1u << 20;
constexpr size_t WS_CTL = 0, CTL_ZERO_BYTES = 1 * MiB;
constexpr size_t WS_SSQP = 1 * MiB;
constexpr size_t WS_TOKE = 3 * MiB;
constexpr size_t WS_TOKG = WS_TOKE + (size_t)M * 4;
constexpr size_t WS_TOKR = WS_TOKG + (size_t)M * 8;
constexpr size_t WS_POS  = WS_TOKR + (size_t)M * 4;
constexpr size_t WS_RSG  = WS_POS + (size_t)M * 8;
constexpr size_t WS_PAR  = WS_RSG + (size_t)SLOTS * 4;
static_assert(WS_PAR + 256 <= 5 * MiB, "small arrays");
constexpr size_t WS_WIN = 5 * MiB;
constexpr size_t WS_WSM = WS_WIN + 2 * (size_t)INW * D * 2;
constexpr size_t WS_WGU = WS_WSM + 6 * (size_t)D * D * 2;
constexpr size_t WS_WDN = WS_WGU + (size_t)2 * FFD * D * 2;
constexpr size_t WS_WEGU = WS_WDN + (size_t)D * FFD * 2;
constexpr size_t WS_WEDN = WS_WEGU + (size_t)NEXP * 2 * FFE * D * 2;
constexpr size_t WS_XB = WS_WEDN + (size_t)NEXP * D * FFE * 2;
constexpr size_t WS_ARENA = WS_XB + (size_t)M * D * 2;
constexpr size_t ZG = (size_t)M * D * 2;
constexpr size_t WS_HD = WS_ARENA;
constexpr size_t WS_XG = WS_ARENA;
constexpr size_t WS_HE = WS_XG + (size_t)SLOTS * D * 2;
constexpr size_t WS_END = WS_HE + (size_t)SLOTS * FFE * 2;
static_assert(WS_ARENA + 8 * ZG <= WS_END && WS_END <= 896 * MiB, "d_ws map");
constexpr int CW_TMO = 0, CW_BAR = 4096, CW_CNT = 8192, CW_CUR = 8192 + 64;

constexpr int RING_OFF = 0, RING_BYTES = 131072;
constexpr int LDSCTL_OFF = RING_BYTES, MISC_OFF = LDSCTL_OFF + 320;
constexpr int LDS_BYTES = 147456;
static_assert(MISC_OFF + 128 <= LDS_BYTES && dattn::LDS_BYTES <= RING_BYTES, "LDS map");

#define GAS __attribute__((address_space(1)))
#define LAS __attribute__((address_space(3)))
typedef unsigned short bf16;
typedef unsigned v4u __attribute__((ext_vector_type(4)));
typedef float f32x4 __attribute__((ext_vector_type(4)));
typedef short bf16x8 __attribute__((ext_vector_type(8)));
typedef GAS unsigned gu32;
typedef GAS unsigned long long gu64;
#define RLX_AGENT __ATOMIC_RELAXED, __HIP_MEMORY_SCOPE_AGENT
#define LDS_WAIT() asm volatile("s_waitcnt lgkmcnt(0)" ::: "memory")
#define VM_WAIT() asm volatile("s_waitcnt vmcnt(0)" ::: "memory")
__device__ __forceinline__ unsigned long long rt() { return __builtin_amdgcn_s_memrealtime(); }
__device__ __forceinline__ unsigned f2bf(float f) { unsigned u = __builtin_bit_cast(unsigned, f); return (u + 0x7fffu + ((u >> 16) & 1u)) >> 16; }
__device__ __forceinline__ unsigned pk2(float lo, float hi) { return f2bf(lo) | (f2bf(hi) << 16); }

#define XB_TMO      128
#define XB_XCNT(j)  (256  + 64 * (j))
#define XB_XSUB(j)  (1280 + 64 * (j))
#define XB_XGEN(j)  (2304 + 64 * (j))
#define XB_TOP      3328
#define XB_TOPGEN   3392
#define XCD_BAR_WORDS 3456
#define XB_SPIN_CAP (1u << 18)

__device__ __forceinline__ unsigned xb_ld(unsigned* p)              { return __hip_atomic_load(p, __ATOMIC_RELAXED, __HIP_MEMORY_SCOPE_AGENT); }
__device__ __forceinline__ unsigned xb_add(unsigned* p, unsigned v) { return __hip_atomic_fetch_add(p, v, __ATOMIC_RELAXED, __HIP_MEMORY_SCOPE_AGENT); }
__device__ __forceinline__ unsigned xb_xcc_id() { return (unsigned)__builtin_amdgcn_s_getreg((3 << 11) | 20) & 0xFu; }
#define XB_SPIN(cond, bar) do { unsigned _sp = 0; while (cond) { __builtin_amdgcn_s_sleep(1); \
    if ((++_sp & 255u) == 0u) { if (xb_ld(&(bar)[XB_TMO])) break; if (_sp > XB_SPIN_CAP) { atomicAdd(&(bar)[XB_TMO], 1u); break; } } } } while (0)

struct XcdBarrier {
    unsigned* bar; unsigned x;
    volatile LAS unsigned* st;
};

__device__ __forceinline__ XcdBarrier xcd_barrier_post(unsigned* bar, volatile LAS unsigned* st) {
    XcdBarrier b; b.bar = bar; b.x = xb_xcc_id(); b.st = st;
    if (threadIdx.x == 0) (void)xb_add(&bar[XB_XCNT(b.x)], 1u);
    return b;
}
__device__ __forceinline__ void xcd_barrier_complete(unsigned* bar, unsigned x, unsigned& nloc, unsigned& nx) {
    const unsigned G = gridDim.x * gridDim.y * gridDim.z;
    unsigned sum, cnt, mine, sp = 0u;
    for (;;) {
        sum = 0u; cnt = 0u; mine = 0u;
#pragma unroll
        for (unsigned j = 0; j < 16; ++j) { const unsigned c = xb_ld(&bar[XB_XCNT(j)]); sum += c; cnt += (c > 0u) ? 1u : 0u; mine = (j == x) ? c : mine; }
        if (sum == G) break;
        __builtin_amdgcn_s_sleep(1);
        if ((++sp & 255u) == 0u) { if (xb_ld(&bar[XB_TMO])) break; if (sp > XB_SPIN_CAP) { atomicAdd(&bar[XB_TMO], 1u); break; } }
    }
    nloc = mine > 0u ? mine : 1u; nx = cnt > 0u ? cnt : 1u;
}

__device__ __forceinline__ void xcd_barrier(const XcdBarrier& b) {
    asm volatile("s_waitcnt vmcnt(0)" ::: "memory");
    __syncthreads();
    if (threadIdx.x == 0) {
        unsigned* bar = b.bar;
        __builtin_amdgcn_s_waitcnt(0);
        unsigned nloc = b.st[0], nx = b.st[1];
        if (nloc == 0u) { xcd_barrier_complete(bar, b.x, nloc, nx); b.st[0] = nloc; b.st[1] = nx; }
        const unsigned old = xb_add(&bar[XB_XSUB(b.x)], 1u);
        const unsigned gen = old / nloc;
        if (old + 1u == (gen + 1u) * nloc) {
            __builtin_amdgcn_fence(__ATOMIC_RELEASE, "agent");
            asm volatile("s_waitcnt vmcnt(0)" ::: "memory");
            const unsigned og = xb_add(&bar[XB_TOP], 1u);
            const unsigned tg = og / nx;
            if (og + 1u == (tg + 1u) * nx) xb_add(&bar[XB_TOPGEN], 1u);
            else XB_SPIN(xb_ld(&bar[XB_TOPGEN]) == tg, bar);
            __builtin_amdgcn_fence(__ATOMIC_ACQUIRE, "agent");
            xb_add(&bar[XB_XGEN(b.x)], 1u);
            asm volatile("s_waitcnt vmcnt(0)" ::: "memory");
        } else {
            XB_SPIN(xb_ld(&bar[XB_XGEN(b.x)]) == gen, bar);
            __builtin_amdgcn_fence(__ATOMIC_ACQUIRE, "agent");
            asm volatile("s_waitcnt vmcnt(0)" ::: "memory");
        }
    }
    __syncthreads();
}

struct Frame {
    LAS unsigned char* lds;
    volatile LAS unsigned* MISC;
    int tid, lane, wave;
    int vcu, G;
};
__device__ __forceinline__ Frame refresh(const Frame& F0) { Frame F = F0; int t = threadIdx.x; asm volatile("" : "+v"(t)); F.tid = t; F.lane = t & 63; F.wave = __builtin_amdgcn_readfirstlane(t >> 6); return F; }
typedef unsigned u32x2_t __attribute__((ext_vector_type(2)));
typedef float f32x2_t __attribute__((ext_vector_type(2)));
typedef int i32x2_t __attribute__((ext_vector_type(2)));
__device__ __forceinline__ float wave_sum(float v) {
#pragma unroll
    for (int o = 1; o < 64; o <<= 1) v += __shfl_xor(v, o);
    return v;
}
__device__ __forceinline__ void unpack8(const v4u w, float (&f)[8]) {
    f[0] = __uint_as_float(w.x << 16); f[1] = __uint_as_float(w.x & 0xffff0000u); f[2] = __uint_as_float(w.y << 16); f[3] = __uint_as_float(w.y & 0xffff0000u);
    f[4] = __uint_as_float(w.z << 16); f[5] = __uint_as_float(w.z & 0xffff0000u); f[6] = __uint_as_float(w.w << 16); f[7] = __uint_as_float(w.w & 0xffff0000u);
}
__device__ __forceinline__ void p0_transpose_item(const float* W, int K, int N, bf16* WT, int orow0, int k0, int n0, const float* gk, float cs, LAS float* scr, int lane) {
#pragma unroll 8
    for (int i = 0; i < 32; ++i) { const int kk = 2 * i + (lane >> 5); const float s = gk ? gk[k0 + kk] * cs : cs; scr[kk * 33 + (lane & 31)] = W[(size_t)(k0 + kk) * N + n0 + (lane & 31)] * s; }
    LDS_WAIT(); asm volatile("" ::: "memory");
    const int c = lane & 7;
#pragma unroll
    for (int j = 0; j < 4; ++j) { const int n = (lane >> 3) + 8 * j; const LAS float* s = scr + (8 * c) * 33 + n;
        v4u o; o.x = pk2(s[0 * 33], s[1 * 33]); o.y = pk2(s[2 * 33], s[3 * 33]); o.z = pk2(s[4 * 33], s[5 * 33]); o.w = pk2(s[6 * 33], s[7 * 33]);
        *(GAS v4u*)(WT + (size_t)(orow0 + n) * K + k0 + 8 * c) = o; }
    LDS_WAIT(); asm volatile("" ::: "memory");
}
__device__ __forceinline__ int gu_row(int n0, int F) { const int bj = n0 / F, j = n0 - bj * F; return 256 * (j >> 7) + 128 * bj + (j & 127); }

struct Args { const float* in[17]; float* out; unsigned char* ws; };
#define AS4 __attribute__((address_space(4)))
__device__ __forceinline__ const AS4 Args* kargs() { const AS4 Args* p = (const AS4 Args*)__builtin_amdgcn_kernarg_segment_ptr(); asm volatile("" : "+s"(p)); return p; }
enum { I_X = 0, I_RELB, I_MIXG, I_WIN, I_LAMQK, I_SUBLN, I_CONVW, I_WOA, I_WOC, I_WO, I_FFNG, I_DGU, I_DDN, I_ROUTER, I_EGU, I_EDN, I_FING };

__device__ __forceinline__ void p0_prologue(const Frame& F0) {
    const Frame F = refresh(F0);
    const AS4 Args* A_ = kargs(); const AS4 Args& A = *A_; unsigned char* const Fws = A.ws;
    LAS float* scr = (LAS float*)(F.lds + RING_OFF + F.wave * 16384);
    const int gw = F.vcu * NWAVES + F.wave, NGW = F.G * NWAVES;
    constexpr int I_A = 2 * 16 * 256, I_B = 6 * 512, I_C = 16 * 176, I_D = 44 * 32, I_E = 8 * 16 * 224, I_F = 8 * 56 * 32;
    constexpr int NITEMS = I_A + I_B + I_C + I_D + I_E + I_F;
    for (int it = gw; it < NITEMS; it += NGW) {
        int r = it;
        if (r < I_A) { const int l = r / 4096, rr = r % 4096, kb = rr / 256, nb = rr % 256;
            p0_transpose_item(A.in[I_WIN] + (size_t)l * D * INW, D, INW, (bf16*)(Fws + WS_WIN) + (size_t)l * INW * D, 32 * nb, 64 * kb, 32 * nb, A.in[I_MIXG] + l * D, nb < 32 ? C2 : 1.f, scr, F.lane); continue; }
        r -= I_A;
        if (r < I_B) { const int idx = r / 512, rr = r % 512, l = idx / 3, which = idx % 3, kb = rr / 32, nb = rr % 32;
            const float* W = (which == 0 ? A.in[I_WOA] : which == 1 ? A.in[I_WOC] : A.in[I_WO]) + (size_t)l * D * D;
            p0_transpose_item(W, D, D, (bf16*)(Fws + WS_WSM) + (size_t)idx * D * D, 32 * nb, 64 * kb, 32 * nb, nullptr, 1.f, scr, F.lane); continue; }
        r -= I_B;
        if (r < I_C) { const int kb = r / 176, nb = r % 176;
            p0_transpose_item(A.in[I_DGU], D, 2 * FFD, (bf16*)(Fws + WS_WGU), gu_row(32 * nb, FFD), 64 * kb, 32 * nb, A.in[I_FFNG], 1.f, scr, F.lane); continue; }
        r -= I_C;
        if (r < I_D) { const int kb = r / 32, nb = r % 32;
            p0_transpose_item(A.in[I_DDN], FFD, D, (bf16*)(Fws + WS_WDN), 32 * nb, 64 * kb, 32 * nb, nullptr, 1.f, scr, F.lane); continue; }
        r -= I_D;
        if (r < I_E) { const int e = r / 3584, rr = r % 3584, kb = rr / 224, nb = rr % 224;
            p0_transpose_item(A.in[I_EGU] + (size_t)e * D * 2 * FFE, D, 2 * FFE, (bf16*)(Fws + WS_WEGU) + (size_t)e * 2 * FFE * D, gu_row(32 * nb, FFE), 64 * kb, 32 * nb, A.in[I_FFNG] + D, 1.f, scr, F.lane); continue; }
        r -= I_E;
        { const int e = r / 1792, rr = r % 1792, kb = rr / 32, nb = rr % 32;
            p0_transpose_item(A.in[I_EDN] + (size_t)e * FFE * D, FFE, D, (bf16*)(Fws + WS_WEDN) + (size_t)e * D * FFE, 32 * nb, 64 * kb, 32 * nb, nullptr, 1.f, scr, F.lane); }
    }
    const float* x = A.in[I_X]; bf16* XB = (bf16*)(Fws + WS_XB); float* ssqp = (float*)(Fws + WS_SSQP);
    for (int m = gw; m < M; m += NGW) {
        const GAS f32x4* xr = (const GAS f32x4*)(x + (size_t)m * D) + F.lane;
        f32x4 v[4]; float s = 0.f;
#pragma unroll
        for (int j = 0; j < 4; ++j) { v[j] = xr[64 * j]; s += (v[j].x * v[j].x + v[j].y * v[j].y) + (v[j].z * v[j].z + v[j].w * v[j].w); }
        s = wave_sum(s);
        GAS unsigned long long* o8 = (GAS unsigned long long*)(XB + (size_t)m * D) + F.lane;
#pragma unroll
        for (int j = 0; j < 4; ++j) o8[64 * j] = (unsigned long long)pk2(v[j].x, v[j].y) | ((unsigned long long)pk2(v[j].z, v[j].w) << 32);
        if (F.lane < 16) ssqp[(size_t)m * 16 + F.lane] = (F.lane == 0) ? s : 0.f;
    }
    if (gw == 0) {
        float* par = (float*)(Fws + WS_PAR);
#pragma unroll
        for (int l = 0; l < 2; ++l) { const float* lq = A.in[I_LAMQK] + l * 256;
            const float sa = wave_sum(lq[F.lane] * lq[64 + F.lane]), sb = wave_sum(lq[128 + F.lane] * lq[192 + F.lane]);
            const float lam_init = (l == 0) ? 0.2f : (0.8f - 0.6f * 0.7408182206817179f);
            if (F.lane == 0) par[l] = expf(sa) - expf(sb) + lam_init; }
    }
}

__device__ __forceinline__ void conv_phase(const Frame& F0, int l) {
    const Frame F = refresh(F0);
    const AS4 Args* A_ = kargs(); unsigned char* const Fws = A_->ws; const float* cw = A_->in[I_CONVW] + (size_t)l * 3 * D;
    const bf16* Hh = (const bf16*)(Fws + WS_ARENA + 3 * ZG); bf16* Bb = (bf16*)(Fws + WS_ARENA + 4 * ZG); const bf16* Cc = (const bf16*)(Fws + WS_ARENA + 5 * ZG);
    const int nthr = F.G * NWAVES * 64, gt = F.vcu * NWAVES * 64 + F.tid;
    for (int idx = gt; idx < M * 128; idx += nthr) {
        const int m = idx >> 7, col = (idx & 127) * 8, t = m & (SEQ - 1); const size_t o = (size_t)m * D + col;
        float h0[8], c0[8], h1[8], c1[8], h2[8], c2[8], bb[8];
        unpack8(*(const v4u*)(Hh + o), h0); unpack8(*(const v4u*)(Cc + o), c0); unpack8(*(const v4u*)(Bb + o), bb);
        if (t >= 1) { unpack8(*(const v4u*)(Hh + o - D), h1); unpack8(*(const v4u*)(Cc + o - D), c1); } else {
#pragma unroll
            for (int i = 0; i < 8; ++i) { h1[i] = 0.f; c1[i] = 0.f; } }
        if (t >= 2) { unpack8(*(const v4u*)(Hh + o - 2 * D), h2); unpack8(*(const v4u*)(Cc + o - 2 * D), c2); } else {
#pragma unroll
            for (int i = 0; i < 8; ++i) { h2[i] = 0.f; c2[i] = 0.f; } }
        float r[8];
#pragma unroll
        for (int i = 0; i < 8; ++i) r[i] = bb[i] * (cw[col + i] * (c2[i] * h2[i]) + cw[D + col + i] * (c1[i] * h1[i]) + cw[2 * D + col + i] * (c0[i] * h0[i]));
        v4u w; w.x = pk2(r[0], r[1]); w.y = pk2(r[2], r[3]); w.z = pk2(r[4], r[5]); w.w = pk2(r[6], r[7]);
        *(v4u*)(Bb + o) = w;
    }
}

__device__ __forceinline__ int router_phase(const Frame& F0) {
    const Frame F = refresh(F0);
    const AS4 Args* A_ = kargs(); unsigned char* const Fws = A_->ws; gu32* const Fctl = (gu32*)(Fws + WS_CTL); const float* xr_ = A_->out; const float* Wr = A_->in[I_ROUTER]; const float* gff = A_->in[I_FFNG] + D;
    const int gw = F.vcu * NWAVES + F.wave, NGW = F.G * NWAVES, rpw = (M + NGW - 1) / NGW;
    unsigned* toke = (unsigned*)(Fws + WS_TOKE); float* tokg = (float*)(Fws + WS_TOKG); float* tokr = (float*)(Fws + WS_TOKR);
    int mycnt = 0;
    const int r0 = gw * rpw, r1 = (r0 + rpw < M) ? r0 + rpw : M;
    for (int m = r0; m < r1; ++m) {
        const f32x4* xr = (const f32x4*)(xr_ + (size_t)m * D) + F.lane;
        float lg[8] = {0.f, 0.f, 0.f, 0.f, 0.f, 0.f, 0.f, 0.f}; float ss = 0.f;
#pragma unroll
        for (int j = 0; j < 4; ++j) { const f32x4 v = xr[64 * j]; ss += (v[0] * v[0] + v[1] * v[1]) + (v[2] * v[2] + v[3] * v[3]);
            const int k0 = 4 * F.lane + 256 * j; const f32x4 gk = *(const f32x4*)(gff + k0);
#pragma unroll
            for (int c = 0; c < 4; ++c) { const float xg = v[c] * gk[c]; const f32x4 a = *(const f32x4*)(Wr + (size_t)(k0 + c) * 8), b = *(const f32x4*)(Wr + (size_t)(k0 + c) * 8 + 4);
                lg[0] += xg * a[0]; lg[1] += xg * a[1]; lg[2] += xg * a[2]; lg[3] += xg * a[3]; lg[4] += xg * b[0]; lg[5] += xg * b[1]; lg[6] += xg * b[2]; lg[7] += xg * b[3]; } }
        ss = wave_sum(ss); const float rs = 1.0f / sqrtf(ss * (1.0f / D) + RMS_EPS);
#pragma unroll
        for (int e = 0; e < 8; ++e) lg[e] = wave_sum(lg[e]) * rs;
        int e1 = 0; float v1 = lg[0];
#pragma unroll
        for (int e = 1; e < 8; ++e) if (lg[e] > v1) { v1 = lg[e]; e1 = e; }
        int e2 = -1; float v2 = -INFINITY;
#pragma unroll
        for (int e = 0; e < 8; ++e) if (e != e1 && lg[e] > v2) { v2 = lg[e]; e2 = e; }
        if (e2 < 0) e2 = (e1 == 0) ? 1 : 0;
        const float ex = expf(v2 - v1), g1 = 1.0f / (1.0f + ex), g2 = ex * g1;
        if (F.lane == 0) { toke[m] = (unsigned)e1 | ((unsigned)e2 << 8); tokg[2 * m] = g1; tokg[2 * m + 1] = g2; tokr[m] = rs; }
        mycnt += (F.lane == e1) ? 1 : 0; mycnt += (F.lane == e2) ? 1 : 0;
    }
    if (F.lane < 8 && mycnt) __hip_atomic_fetch_add((unsigned*)(Fctl + CW_CNT) + F.lane, (unsigned)mycnt, __ATOMIC_RELAXED, __HIP_MEMORY_SCOPE_AGENT);
    return mycnt;
}
__device__ __forceinline__ int moe_bases(const Frame& F0, int& total) {
    const Frame F = refresh(F0);
    const AS4 Args* A_ = kargs(); gu32* const Fctl = (gu32*)(A_->ws + WS_CTL);
    const unsigned c8 = __hip_atomic_load((unsigned*)(Fctl + CW_CNT) + (F.lane & 7), __ATOMIC_RELAXED, __HIP_MEMORY_SCOPE_AGENT);
    const int rp = (int)((c8 + 255u) & ~255u); int pb = 0, tot = 0;
#pragma unroll
    for (int k = 0; k < 8; ++k) { const int v = __shfl(rp, k); tot += v; if (k < (F.lane & 7)) pb += v; }
    total = tot; return pb;
}
__device__ __forceinline__ void gather_phase(const Frame& F0, int mycnt) {
    const Frame F = refresh(F0);
    const AS4 Args* A_ = kargs(); unsigned char* const Fws = A_->ws; gu32* const Fctl = (gu32*)(Fws + WS_CTL);
    const int gw = F.vcu * NWAVES + F.wave, NGW = F.G * NWAVES, rpw = (M + NGW - 1) / NGW;
    const unsigned* toke = (const unsigned*)(Fws + WS_TOKE); const float* tokr = (const float*)(Fws + WS_TOKR);
    int* pos = (int*)(Fws + WS_POS); float* rsg = (float*)(Fws + WS_RSG);
    const bf16* XB = (const bf16*)(Fws + WS_XB); bf16* XG = (bf16*)(Fws + WS_XG);
    int total; int wb = moe_bases(F, total);
    if (F.lane < 8 && mycnt) wb += (int)__hip_atomic_fetch_add((unsigned*)(Fctl + CW_CUR) + F.lane, (unsigned)mycnt, __ATOMIC_RELAXED, __HIP_MEMORY_SCOPE_AGENT);
    const int r0 = gw * rpw, r1 = (r0 + rpw < M) ? r0 + rpw : M;
    for (int m = r0; m < r1; ++m) {
        const unsigned ee = toke[m]; const int e1 = (int)(ee & 255u), e2 = (int)(ee >> 8);
        const int s1 = __shfl(wb, e1); if (F.lane == e1) ++wb;
        const int s2 = __shfl(wb, e2); if (F.lane == e2) ++wb;
        const v4u* src = (const v4u*)(XB + (size_t)m * D) + F.lane; const v4u a = src[0], b = src[64];
        v4u* d1 = (v4u*)(XG + (size_t)s1 * D) + F.lane; v4u* d2 = (v4u*)(XG + (size_t)s2 * D) + F.lane;
        d1[0] = a; d1[64] = b; d2[0] = a; d2[64] = b;
        if (F.lane == 0) { const float r = tokr[m]; pos[2 * m] = s1; pos[2 * m + 1] = s2; rsg[s1] = r; rsg[s2] = r; }
    }
}
__device__ __forceinline__ void combine_phase(const Frame& F0) {
    const Frame F = refresh(F0);
    const AS4 Args* A_ = kargs(); unsigned char* const Fws = A_->ws; const float* xr_ = A_->out; float* out = A_->out; const float* gfin = A_->in[I_FING];
    const int gw = F.vcu * NWAVES + F.wave, NGW = F.G * NWAVES;
    const float* tokg = (const float*)(Fws + WS_TOKG); const int* pos = (const int*)(Fws + WS_POS); const bf16* Y = (const bf16*)(Fws + WS_XG);
    f32x4 gf[4];
#pragma unroll
    for (int j = 0; j < 4; ++j) gf[j] = ((const f32x4*)gfin)[F.lane + 64 * j];
    for (int m = gw; m < M; m += NGW) {
        const int s1 = pos[2 * m], s2 = pos[2 * m + 1]; const float g1 = tokg[2 * m], g2 = tokg[2 * m + 1];
        const f32x4* xr = (const f32x4*)(xr_ + (size_t)m * D) + F.lane;
        const u32x2_t* y1 = (const u32x2_t*)(Y + (size_t)s1 * D) + F.lane; const u32x2_t* y2 = (const u32x2_t*)(Y + (size_t)s2 * D) + F.lane;
        f32x4 v[4]; float ss = 0.f;
#pragma unroll
        for (int j = 0; j < 4; ++j) { const f32x4 xv = xr[64 * j]; const u32x2_t a = y1[64 * j], b = y2[64 * j];
            v[j][0] = xv[0] + g1 * __uint_as_float(a.x << 16) + g2 * __uint_as_float(b.x << 16);
            v[j][1] = xv[1] + g1 * __uint_as_float(a.x & 0xffff0000u) + g2 * __uint_as_float(b.x & 0xffff0000u);
            v[j][2] = xv[2] + g1 * __uint_as_float(a.y << 16) + g2 * __uint_as_float(b.y << 16);
            v[j][3] = xv[3] + g1 * __uint_as_float(a.y & 0xffff0000u) + g2 * __uint_as_float(b.y & 0xffff0000u);
            ss += (v[j][0] * v[j][0] + v[j][1] * v[j][1]) + (v[j][2] * v[j][2] + v[j][3] * v[j][3]); }
        ss = wave_sum(ss); const float rs = 1.0f / sqrtf(ss * (1.0f / D) + RMS_EPS);
        f32x4* o = (f32x4*)(out + (size_t)m * D) + F.lane;
#pragma unroll
        for (int j = 0; j < 4; ++j) o[64 * j] = v[j] * rs * gf[j];
    }
}

#ifndef PHASE_MASK
#define PHASE_MASK 0xFFFF
#endif
#define PH(b) ((PHASE_MASK >> (b)) & 1)
__global__ void __launch_bounds__(NWAVES * 64, 2) mega_fwd(Args args) {
    extern __shared__ __attribute__((aligned(16))) unsigned char lds[];
    Frame F;
    F.lds = (LAS unsigned char*)lds;
    F.MISC = (volatile LAS unsigned*)(F.lds + MISC_OFF);
    F.tid = threadIdx.x; F.lane = F.tid & 63; F.wave = __builtin_amdgcn_readfirstlane(F.tid >> 6);
    F.G = gridDim.x; { const int bx = blockIdx.x; F.vcu = (F.G % 8 == 0) ? (bx % 8) * (F.G / 8) + bx / 8 : bx; }
    for (int u = F.tid; u < (LDS_BYTES - LDSCTL_OFF) / 4; u += NWAVES * 64) ((LAS unsigned*)(F.lds + LDSCTL_OFF))[u] = 0u;
    __syncthreads();
    XcdBarrier bar = xcd_barrier_post((unsigned*)(args.ws + WS_CTL) + CW_BAR, F.MISC + 8);
#define GRID_BAR() do { XcdBarrier b2_ = bar; b2_.bar = (unsigned*)(kargs()->ws + WS_CTL) + CW_BAR; asm volatile("" : "+s"(b2_.x)); xcd_barrier(b2_); } while (0)
#define PHASE_PTRS() const AS4 Args* ka = kargs(); unsigned char* const ws = ka->ws; bf16* const XB = (bf16*)(ws + WS_XB); float* const XR = ka->out; float* const ssqp = (float*)(ws + WS_SSQP); bf16* const Z = (bf16*)(ws + WS_ARENA); \
    (void)XB; (void)XR; (void)ssqp; (void)Z
    constexpr size_t ZGE = ZG / 2;

    if (PH(0)) p0_prologue(F);
    GRID_BAR();

    for (int l = 0; l < 2; ++l) {
        if (PH(1)) { PHASE_PTRS(); pg8::Gemm g{XB, (const bf16*)(ws + WS_WIN) + (size_t)l * INW * D, M, INW, D}; pg8::StaticOrder S; S.init(M, INW, F.G, (int)blockIdx.x);
          pg8::EpiInProj E{Z, ZGE, pg8::RowScaleP16{ssqp}};
          pg8::gemm_phase<pg8::EpiInProj, pg8::StaticOrder, true, true>(F.lds + RING_OFF, g, S, E); }
        GRID_BAR();
        if (PH(2)) conv_phase(F, l);
        if (PH(3)) { PHASE_PTRS(); const float lam = ((const float*)(ws + WS_PAR))[l]; const float lam_init = (l == 0) ? 0.2f : (0.8f - 0.6f * 0.7408182206817179f);
          const float* gsub = ka->in[I_SUBLN] + l * 128; const float* relb = ka->in[I_RELB];
          const bool bal = (F.G == 256); const int Lend = bal ? F.vcu * 4 + 4 : 1024, Lstep = bal ? 1 : F.G;
          for (int L = bal ? F.vcu * 4 : F.vcu; L < Lend; L += Lstep) {
              const int bh = L >> 6, p = L & 63;
#pragma unroll 1
              for (int s = 0; s < 2; ++s) { const int qb = s ? 127 - p : p;
                  dattn::attn_unit(bh >> 3, bh & 7, qb, Z, Z + ZGE, Z + 2 * ZGE, Z, relb, lam, gsub, 1.f - lam_init, (char*)lds + RING_OFF); }
          }
          __syncthreads(); }
        GRID_BAR();
        if (PH(4)) { PHASE_PTRS(); pg8::Gemm g{Z, (const bf16*)(ws + WS_WSM) + (size_t)(l * 3 + 0) * D * D, M, D, D}; pg8::StaticOrder S; S.init(M, D, F.G, (int)blockIdx.x);
          pg8::EpiGateA E{Z + 6 * ZGE};
          pg8::gemm_phase<pg8::EpiGateA, pg8::StaticOrder, true, true>(F.lds + RING_OFF, g, S, E); }
        if (PH(5)) { PHASE_PTRS(); pg8::Gemm g{Z + 4 * ZGE, (const bf16*)(ws + WS_WSM) + (size_t)(l * 3 + 1) * D * D, M, D, D}; pg8::StaticOrder S; S.init(M, D, F.G, (int)blockIdx.x);
          pg8::EpiGateB E{Z + 6 * ZGE, Z + 7 * ZGE};
          pg8::gemm_phase<pg8::EpiGateB, pg8::StaticOrder, true, true>(F.lds + RING_OFF, g, S, E); }
        GRID_BAR();
        if (PH(6)) { PHASE_PTRS(); pg8::Gemm g{Z + 6 * ZGE, (const bf16*)(ws + WS_WSM) + (size_t)(l * 3 + 2) * D * D, M, D, D}; pg8::StaticOrder S; S.init(M, D, F.G, (int)blockIdx.x);
          pg8::EpiResid E{(l == 0) ? ka->in[I_X] : (const float*)XR, XR, XB, ssqp};
          pg8::gemm_phase<pg8::EpiResid, pg8::StaticOrder, true, true>(F.lds + RING_OFF, g, S, E); }
        GRID_BAR();
        if (l == 0) {
            if (PH(7)) { PHASE_PTRS(); pg8::Gemm g{XB, (const bf16*)(ws + WS_WGU), M, 2 * FFD, D}; pg8::StaticOrder S; S.init(M, 2 * FFD, F.G, (int)blockIdx.x);
              pg8::EpiSwiGLU<pg8::RowScaleP16> E{(bf16*)(ws + WS_HD), FFD, pg8::RowScaleP16{ssqp}};
              pg8::gemm_phase<pg8::EpiSwiGLU<pg8::RowScaleP16>, pg8::StaticOrder, true, true>(F.lds + RING_OFF, g, S, E); }
            GRID_BAR();
            if (PH(8)) { PHASE_PTRS(); pg8::Gemm g{(const bf16*)(ws + WS_HD), (const bf16*)(ws + WS_WDN), M, D, FFD}; pg8::StaticOrder S; S.init(M, D, F.G, (int)blockIdx.x);
              pg8::EpiResid E{XR, XR, XB, ssqp};
              pg8::gemm_phase<pg8::EpiResid, pg8::StaticOrder, true, true>(F.lds + RING_OFF, g, S, E); }
            GRID_BAR();
        } else {
            const int mycnt = PH(9) ? router_phase(F) : 0;
            GRID_BAR();
            if (PH(10)) gather_phase(F, mycnt);
            GRID_BAR();
            if (PH(11)) { PHASE_PTRS(); int total; const int pb = moe_bases(F, total); const int npan = __builtin_amdgcn_readfirstlane(total) >> 8;
              pg8::Gemm g{(const bf16*)(ws + WS_XG), (const bf16*)(ws + WS_WEGU), SLOTS, 2 * FFE, D}; pg8::MoeOrder S; S.init(npan, 2 * FFE, F.G, (int)blockIdx.x, 2 * FFE);
#pragma unroll
              for (int k = 0; k < 8; ++k) S.ps[k] = __builtin_amdgcn_readfirstlane(__shfl(pb, k)) >> 8;
              pg8::EpiSwiGLU<pg8::RowScaleDirect> E{(bf16*)(ws + WS_HE), FFE, pg8::RowScaleDirect{(const float*)(ws + WS_RSG)}};
              pg8::gemm_phase<pg8::EpiSwiGLU<pg8::RowScaleDirect>, pg8::MoeOrder, true, true>(F.lds + RING_OFF, g, S, E); }
            GRID_BAR();
            if (PH(12)) { PHASE_PTRS(); int total; const int pb = moe_bases(F, total); const int npan = __builtin_amdgcn_readfirstlane(total) >> 8;
              pg8::Gemm g{(const bf16*)(ws + WS_HE), (const bf16*)(ws + WS_WEDN), SLOTS, D, FFE}; pg8::MoeOrder S; S.init(npan, D, F.G, (int)blockIdx.x, D);
#pragma unroll
              for (int k = 0; k < 8; ++k) S.ps[k] = __builtin_amdgcn_readfirstlane(__shfl(pb, k)) >> 8;
              pg8::EpiPlainBf16 E{(bf16*)(ws + WS_XG), D};
              pg8::gemm_phase<pg8::EpiPlainBf16, pg8::MoeOrder, true, true>(F.lds + RING_OFF, g, S, E); }
            GRID_BAR();
            if (PH(13)) combine_phase(F);
        }
    }
#undef GRID_BAR
#undef PHASE_PTRS
}

extern "C" void kernel_launch(void* const* d_in, const int* in_sizes, int n_in, void* d_out, int out_size, void* d_ws, size_t ws_size, hipStream_t stream) {
    static int grid = 0;
    if (grid == 0) {
        if (n_in != 17 || in_sizes[0] != M * D || out_size != M * D || ws_size < WS_END) { fprintf(stderr, "kernel_launch: shape/workspace mismatch: n_in %d in0 %d out %d ws %zu (need %zu)\n", n_in, n_in > 0 ? in_sizes[0] : -1, out_size, ws_size, (size_t)WS_END); grid = -1; return; }
        int dev = 0, cus = 0, per_cu = 0;
        if (hipGetDevice(&dev) != hipSuccess || hipDeviceGetAttribute(&cus, hipDeviceAttributeMultiprocessorCount, dev) != hipSuccess) { grid = -1; return; }
        if (hipFuncSetAttribute((const void*)mega_fwd, hipFuncAttributeMaxDynamicSharedMemorySize, LDS_BYTES) != hipSuccess) { fprintf(stderr, "kernel_launch: hipFuncSetAttribute failed\n"); grid = -1; return; }
        if (hipOccupancyMaxActiveBlocksPerMultiprocessor(&per_cu, (const void*)mega_fwd, NWAVES * 64, LDS_BYTES) != hipSuccess || per_cu < 1) { fprintf(stderr, "kernel_launch: occupancy query reports %d\n", per_cu); }
        (void)hipGetLastError();
        grid = cus;
    }
    if (grid < 0) return;
    if (hipMemsetAsync((char*)d_ws + WS_CTL, 0, CTL_ZERO_BYTES, stream) != hipSuccess) return;
    Args a{};
    for (int i = 0; i < 17; ++i) a.in[i] = (const float*)d_in[i];
    a.out = (float*)d_out; a.ws = (unsigned char*)d_ws;
    hipLaunchKernelGGL(mega_fwd, dim3(grid), dim3(NWAVES * 64), LDS_BYTES, stream, a);
    const hipError_t le = hipPeekAtLastError();
    if (le != hipSuccess) fprintf(stderr, "kernel_launch: launch failed: %s\n", hipGetErrorName(le));
}
```

```cpp
#include <hip/hip_runtime.h>
#include <hip/hip_bf16.h>
#include <cstdio>
#include <cstdint>
#include <cmath>

#ifndef MK_N_LAUNCHES
#define MK_N_LAUNCHES 1
#endif

namespace pg8 {
#define PG8_LAS __attribute__((address_space(3)))
typedef unsigned short bf16_t;
typedef short bf16x8 __attribute__((ext_vector_type(8)));
typedef float f32x4 __attribute__((ext_vector_type(4)));
typedef unsigned u32x4 __attribute__((ext_vector_type(4)));
typedef unsigned u32x2 __attribute__((ext_vector_type(2)));
constexpr int BM = 256, BK = 64, HALF = 128, HTB = HALF * BK * 2  , STAGE_BYTES = 8 * HTB, NXCD = 8, WGM = 8;

__host__ __device__ __forceinline__ int lds_byte(int r, int c) { const int st = (r >> 4) * 2 + (c >> 5), rr = r & 15, cc = c & 31, ob = rr * 64 + cc * 2; return st * 1024 + (ob ^ (((ob >> 9) & 1) << 5)); }
__host__ __device__ __forceinline__ void stage_rc(int b, int& R, int& C) { const int st = b / 1024, sb = b % 1024, swz = sb ^ (((sb >> 9) & 1) << 5); R = (st >> 1) * 16 + swz / 64; C = (st & 1) * 32 + (swz % 64) / 2; }
__host__ __device__ __forceinline__ int perm32(int rho) { const int n = rho >> 4, i = rho & 15; return 8 * (i >> 2) + 4 * n + (i & 3); }

struct Unit { int pm, pn, be, seg; };
struct Gemm { const bf16_t* A; const bf16_t* Bt; int M, N, K; const bf16_t* A2; const bf16_t* Bt2; };

struct StaticOrder {
    int nM, nN, nwg, G, c;
    __host__ __device__ void init(int M, int N, int G_, int c_) { nM = M / BM; nN = N / BM; nwg = nM * nN; G = G_; c = c_; }
    __host__ __device__ bool next(int i, Unit& u) const {
        const long L = (long)i * G + c; if (L >= nwg) return false;
        int wgid = (int)L; { const int q = nwg / NXCD, r = nwg % NXCD, xcd = wgid % NXCD, off = wgid / NXCD; wgid = (xcd < r ? xcd * (q + 1) : r * (q + 1) + (xcd - r) * q) + off; }
        const int nig = WGM * nN, gid = wgid / nig, fm = gid * WGM, gsz = (nM - fm) < WGM ? (nM - fm) : WGM;
        u.pm = fm + ((wgid % nig) % gsz); u.pn = (wgid % nig) / gsz; u.be = 0; u.seg = 0; return true;
    }
    __device__ __forceinline__ void a_ready(const Unit&) const {}
    __device__ __forceinline__ void done(const Unit&) const {}
};
struct PairOrder {
    StaticOrder so;
    __device__ __forceinline__ void init(int M, int N, int G_, int c_) { so.init(M, N, G_, c_); }
    __device__ __forceinline__ bool next(int i, Unit& u) const { if (!so.next(i >> 1, u)) return false; u.seg = i & 1; return true; }
    __device__ __forceinline__ void a_ready(const Unit&) const {}
    __device__ __forceinline__ void done(const Unit&) const {}
};
struct InProjOrder {
    StaticOrder so;
    __device__ __forceinline__ void init(int M, int N, int G_, int c_) { so.init(M, N, G_, c_); }
    __device__ __forceinline__ bool next(int i, Unit& u) const { if (!so.next(i, u)) return false; if (u.pn >= 8 && u.pn < 12) { const int t = u.pm; u.pm = u.pn; u.pn = t; u.seg = 1; } return true; }
    __device__ __forceinline__ void a_ready(const Unit&) const {}
    __device__ __forceinline__ void done(const Unit&) const {}
};
struct MoeOrder {
    int nM, nN, nwg, G, c, erows; int ps[8];
    __device__ __forceinline__ void init(int npan, int N, int G_, int c_, int erows_) { nM = npan; nN = N / BM; nwg = nM * nN; G = G_; c = c_; erows = erows_; }
    __device__ __forceinline__ bool next(int i, Unit& u) const {
        const long L = (long)i * G + c; if (L >= nwg) return false;
        int wgid = (int)L; { const int q = nwg / NXCD, r = nwg % NXCD, xcd = wgid % NXCD, off = wgid / NXCD; wgid = (xcd < r ? xcd * (q + 1) : r * (q + 1) + (xcd - r) * q) + off; }
        const int nig = WGM * nN, gid = wgid / nig, fm = gid * WGM, gsz = (nM - fm) < WGM ? (nM - fm) : WGM;
        u.pm = fm + ((wgid % nig) % gsz); u.pn = (wgid % nig) / gsz;
        int e = 0;
#pragma unroll
        for (int k = 1; k < 8; ++k) e += (u.pm >= ps[k]) ? 1 : 0;
        u.be = e * erows; u.seg = 0; return true;
    }
    __device__ __forceinline__ void a_ready(const Unit&) const {}
    __device__ __forceinline__ void done(const Unit&) const {}
};

__device__ __forceinline__ unsigned cvt_pk_bf16(float lo, float hi) { unsigned r; asm volatile("v_cvt_pk_bf16_f32 %0, %1, %2" : "=v"(r) : "v"(lo), "v"(hi)); return r; }
__device__ __forceinline__ float bf_lo(unsigned w) { return __uint_as_float(w << 16); }
__device__ __forceinline__ float bf_hi(unsigned w) { return __uint_as_float(w & 0xffff0000u); }
__device__ __forceinline__ float sigmoidf_(float x) { return __builtin_amdgcn_rcpf(1.f + __builtin_amdgcn_exp2f(-1.4426950408889634f * x)); }
__device__ __forceinline__ u32x4 pack8(const f32x4 a, const f32x4 b) { u32x4 w; w.x = cvt_pk_bf16(a[0], a[1]); w.y = cvt_pk_bf16(a[2], a[3]); w.z = cvt_pk_bf16(b[0], b[1]); w.w = cvt_pk_bf16(b[2], b[3]); return w; }

__device__ __forceinline__ unsigned pack4_fp8(float a, float b, float c, float d) { unsigned w = 0; w = __builtin_amdgcn_cvt_pk_fp8_f32(a, b, w, false); w = __builtin_amdgcn_cvt_pk_fp8_f32(c, d, w, true); return w; }
struct RowScaleP16 { const float* p;
    __device__ __forceinline__ float get(int row, int fq) const { const f32x4 a = ((const f32x4*)(p + (size_t)row * 16))[fq];
        float s = (a[0] + a[1]) + (a[2] + a[3]); s += __shfl_xor(s, 16); s += __shfl_xor(s, 32);
        return __builtin_amdgcn_rsqf(s * (1.0f / 1024.0f) + 1e-6f); } };
struct RowScaleDirect { const float* rs; __device__ __forceinline__ float get(int row, int) const { return rs[row]; } };

template <long BHD> struct EpiInProj {
    static constexpr bool PERM = true, AFTER_DRAIN = false, HAS_MID = false;
    bf16_t* Z; size_t gstride; const float* xs; const float* wcs; float qscale; unsigned* kmax; const float* cw;
    __device__ __forceinline__ void operator()(const f32x4 (&acc)[2][2][4][2], const Unit& u, int wr, int wc, int fr, int fq) const {
        const int row0 = u.pm * BM + wr * 64 + fr; f32x4 cs[2][2]; float s8[2][4];
        const bool vt = u.seg != 0;
        const bool uc = !vt && (u.pn >= 12 && u.pn < 20);
        const int grp = vt ? 2 : u.pn < 12 ? (u.pn >> 2) : uc ? 3 : u.pn < 24 ? 4 : u.pn < 28 ? 6 : 7; const bool sig = grp >= 6;
        const float gs = (grp == 0) ? qscale : 1.f;
        const float* rsc = vt ? wcs : xs; const float* csc = vt ? xs : wcs;
#pragma unroll
        for (int ai = 0; ai < 2; ++ai)
#pragma unroll
            for (int m = 0; m < 4; ++m) s8[ai][m] = rsc[row0 + ai * HALF + m * 16];
#pragma unroll
        for (int bj = 0; bj < 2; ++bj)
#pragma unroll
            for (int n = 0; n < 2; ++n) cs[bj][n] = *(const f32x4*)(csc + u.pn * BM + bj * HALF + wc * 32 + 8 * fq + 4 * n) * gs;
        bf16_t* base = Z + (size_t)grp * gstride;
        if (vt) {
            constexpr int VT_SEQ = 16384;
            const int tok0 = u.pn * BM + wc * 32 + 16 * (fq >> 1) + 4 * (fq & 1); bf16_t* vb = base + (size_t)(tok0 / VT_SEQ) * 1024 * VT_SEQ + (tok0 & (VT_SEQ - 1));
#pragma unroll
            for (int ai = 0; ai < 2; ++ai)
#pragma unroll
                for (int m = 0; m < 4; ++m) { const int ch = row0 + ai * HALF + m * 16 - 2048; const float s = s8[ai][m]; bf16_t* rp = vb + (size_t)ch * VT_SEQ;
#pragma unroll
                    for (int bj = 0; bj < 2; ++bj) { const f32x4 v0 = acc[ai][bj][m][0] * s * cs[bj][0], v1 = acc[ai][bj][m][1] * s * cs[bj][1]; u32x2 w0, w1;
                        w0.x = cvt_pk_bf16(v0[0], v0[1]); w0.y = cvt_pk_bf16(v0[2], v0[3]); w1.x = cvt_pk_bf16(v1[0], v1[1]); w1.y = cvt_pk_bf16(v1[2], v1[3]);
                        *(u32x2*)(rp + bj * HALF) = w0; *(u32x2*)(rp + bj * HALF + 8) = w1; } }
            return; }
        if (uc) { const int col0 = (u.pn - 12) * HALF + wc * 32 + 8 * fq;
#pragma unroll
            for (int ai = 0; ai < 2; ++ai)
#pragma unroll
                for (int m = 0; m < 4; ++m) { const int row = row0 + ai * HALF + m * 16; const float s = s8[ai][m]; f32x4 uu[2];
#pragma unroll
                    for (int n = 0; n < 2; ++n) uu[n] = (acc[ai][0][m][n] * s * cs[0][n]) * (acc[ai][1][m][n] * s * cs[1][n]);
                    *(u32x4*)(base + (size_t)row * 1024 + col0) = pack8(uu[0], uu[1]); }
            return; }
        if (!vt && u.pn >= 20 && u.pn < 24) {
            const int g_ = u.pn - 20; const bf16_t* ug = Z + 3 * gstride; bf16_t* bh = (bf16_t*)((char*)const_cast<float*>(xs) + BHD); const bool fuse = cw != nullptr;
            int fqo = fq, fro = row0; asm volatile("" : "+v"(fqo), "+v"(fro));
#pragma unroll
            for (int bj = 0; bj < 2; ++bj)
#pragma unroll
                for (int n = 0; n < 2; ++n) { const int ch0 = HALF * (g_ + 4 * bj) + wc * 32 + 8 * fqo + 4 * n;
                    if (!fuse) {
#pragma unroll
                        for (int ai = 0; ai < 2; ++ai)
#pragma unroll
                            for (int m = 0; m < 4; ++m) { const int row = fro + ai * HALF + m * 16; const f32x4 v = acc[ai][bj][m][n] * s8[ai][m] * cs[bj][n];
                                u32x2 w; w.x = cvt_pk_bf16(v[0], v[1]); w.y = cvt_pk_bf16(v[2], v[3]); *(u32x2*)(base + (size_t)row * 1024 + ch0) = w; }
                    } else {
                        const f32x4 w0 = *(const f32x4*)(cw + ch0), w1 = *(const f32x4*)(cw + 1024 + ch0), w2 = *(const f32x4*)(cw + 2048 + ch0);
#pragma unroll
                        for (int ai = 0; ai < 2; ++ai)
#pragma unroll
                            for (int m = 0; m < 4; ++m) { const int row = fro + ai * HALF + m * 16; const f32x4 v = acc[ai][bj][m][n] * s8[ai][m] * cs[bj][n];
                                const u32x2 ua = *(const u32x2*)(ug + (size_t)row * 1024 + ch0), ub = *(const u32x2*)(ug + (size_t)(row - 1) * 1024 + ch0), uc_ = *(const u32x2*)(ug + (size_t)(row - 2) * 1024 + ch0);
                                const f32x4 a0 = {bf_lo(ua.x), bf_hi(ua.x), bf_lo(ua.y), bf_hi(ua.y)}, b0 = {bf_lo(ub.x), bf_hi(ub.x), bf_lo(ub.y), bf_hi(ub.y)}, c0 = {bf_lo(uc_.x), bf_hi(uc_.x), bf_lo(uc_.y), bf_hi(uc_.y)};
                                const bool head = (row & 255) < 2; const f32x4 r = head ? v : v * (w0 * c0 + w1 * b0 + w2 * a0);
                                bf16_t* dst = head ? bh + (size_t)((row >> 8) * 2 + (row & 255)) * 1024 + ch0 : base + (size_t)row * 1024 + ch0;
                                u32x2 w; w.x = cvt_pk_bf16(r[0], r[1]); w.y = cvt_pk_bf16(r[2], r[3]); *(u32x2*)dst = w; } } }
            return; }
        const int col0 = (u.pn & 3) * BM + wc * 32 + 8 * fq; float km[2] = {0.f, 0.f};
#pragma unroll
        for (int ai = 0; ai < 2; ++ai)
#pragma unroll
            for (int m = 0; m < 4; ++m) { const int row = row0 + ai * HALF + m * 16; const float s = s8[ai][m]; bf16_t* rowp = base + (size_t)row * 1024 + col0;
#pragma unroll
                for (int bj = 0; bj < 2; ++bj) { f32x4 v0 = acc[ai][bj][m][0] * s * cs[bj][0], v1 = acc[ai][bj][m][1] * s * cs[bj][1];
                    if (grp == 1) km[bj] = fmaxf(fmaxf(fmaxf(km[bj], fmaxf(fabsf(v0[0]), fabsf(v0[1]))), fmaxf(fabsf(v0[2]), fabsf(v0[3]))), fmaxf(fmaxf(fabsf(v1[0]), fabsf(v1[1])), fmaxf(fabsf(v1[2]), fabsf(v1[3]))));
                    if (sig) {
                        unsigned b0 = 0, b1 = 0;
#pragma unroll
                        for (int i = 0; i < 4; ++i) { b0 |= (unsigned)__builtin_rintf(sigmoidf_(v0[i]) * 255.f) << (8 * i); b1 |= (unsigned)__builtin_rintf(sigmoidf_(v1[i]) * 255.f) << (8 * i); }
                        u32x2 w; w.x = b0; w.y = b1; *(u32x2*)((unsigned char*)base + (size_t)row * 1024 + col0 + bj * HALF) = w; }
                    else *(u32x4*)(rowp + bj * HALF) = pack8(v0, v1); } }
        if (grp == 1) {
#pragma unroll
            for (int bj = 0; bj < 2; ++bj) { float v = km[bj];
#pragma unroll
                for (int sft = 32; sft >= 1; sft >>= 1) v = fmaxf(v, __shfl_xor(v, sft));
                if (fr == 0 && fq == 0) atomicMax(kmax + ((u.pm >> 6) * 16 + ((u.pn & 3) * 2 + bj) * 2 + (wc >> 1)), __float_as_uint(v)); } }
    }
};
__device__ __forceinline__ f32x4 ub4(unsigned w) { return (f32x4){(float)(w & 255u), (float)((w >> 8) & 255u), (float)((w >> 16) & 255u), (float)(w >> 24)} * (1.0f / 255.0f); }
struct EpiGateFused {
    static constexpr bool PERM = true, AFTER_DRAIN = false, HAS_MID = true;
    const unsigned char* Ga8; const unsigned char* Gc8; bf16_t* P;
    __device__ __forceinline__ static f32x4 gcl(unsigned w) { const f32x4 g = ub4(w); return (f32x4){fmaxf(g[0], 0.5f / 255.f), fmaxf(g[1], 0.5f / 255.f), fmaxf(g[2], 0.5f / 255.f), fmaxf(g[3], 0.5f / 255.f)}; }
    __device__ __forceinline__ void mid(f32x4 (&acc)[2][2][4][2], const Unit& u, int wr, int wc, int fr, int fq) const {
        const int col0 = u.pn * BM + wc * 32 + 8 * fq, row0 = u.pm * BM + wr * 64 + fr;
#pragma unroll
        for (int ai = 0; ai < 2; ++ai) { u32x2 ga[4][2], gc[4][2];
#pragma unroll
            for (int m = 0; m < 4; ++m)
#pragma unroll
                for (int bj = 0; bj < 2; ++bj) { const size_t off = (size_t)(row0 + ai * HALF + m * 16) * 1024 + col0 + bj * HALF; ga[m][bj] = *(const u32x2*)(Ga8 + off); gc[m][bj] = *(const u32x2*)(Gc8 + off); }
#pragma unroll
            for (int m = 0; m < 4; ++m)
#pragma unroll
                for (int bj = 0; bj < 2; ++bj) { const f32x4 c0 = gcl(gc[m][bj].x), c1 = gcl(gc[m][bj].y);
                    const f32x4 r0 = ub4(ga[m][bj].x) * (f32x4){__builtin_amdgcn_rcpf(c0[0]), __builtin_amdgcn_rcpf(c0[1]), __builtin_amdgcn_rcpf(c0[2]), __builtin_amdgcn_rcpf(c0[3])};
                    const f32x4 r1 = ub4(ga[m][bj].y) * (f32x4){__builtin_amdgcn_rcpf(c1[0]), __builtin_amdgcn_rcpf(c1[1]), __builtin_amdgcn_rcpf(c1[2]), __builtin_amdgcn_rcpf(c1[3])};
                    acc[ai][bj][m][0] = acc[ai][bj][m][0] * r0; acc[ai][bj][m][1] = acc[ai][bj][m][1] * r1; } }
    }
    __device__ __forceinline__ void operator()(const f32x4 (&acc)[2][2][4][2], const Unit& u, int wr, int wc, int fr, int fq) const {
        const int col0 = u.pn * BM + wc * 32 + 8 * fq, row0 = u.pm * BM + wr * 64 + fr;
        u32x2 gc[2][4][2];
#pragma unroll
        for (int ai = 0; ai < 2; ++ai)
#pragma unroll
            for (int m = 0; m < 4; ++m)
#pragma unroll
                for (int bj = 0; bj < 2; ++bj) gc[ai][m][bj] = *(const u32x2*)(Gc8 + (size_t)(row0 + ai * HALF + m * 16) * 1024 + col0 + bj * HALF);
#pragma unroll
        for (int ai = 0; ai < 2; ++ai)
#pragma unroll
            for (int m = 0; m < 4; ++m) { const size_t off = (size_t)(row0 + ai * HALF + m * 16) * 1024 + col0;
#pragma unroll
                for (int bj = 0; bj < 2; ++bj) *(u32x4*)(P + off + bj * HALF) = pack8(gcl(gc[ai][m][bj].x) * acc[ai][bj][m][0], gcl(gc[ai][m][bj].y) * acc[ai][bj][m][1]); }
    }
};
struct EpiGateA {
    static constexpr bool PERM = true, AFTER_DRAIN = false, HAS_MID = false;
    const unsigned char* G8; bf16_t* P;
    __device__ __forceinline__ void operator()(const f32x4 (&acc)[2][2][4][2], const Unit& u, int wr, int wc, int fr, int fq) const {
        const int col0 = u.pn * BM + wc * 32 + 8 * fq, row0 = u.pm * BM + wr * 64 + fr;
#pragma unroll
        for (int ai = 0; ai < 2; ++ai)
#pragma unroll
            for (int m = 0; m < 4; ++m) { const size_t off = (size_t)(row0 + ai * HALF + m * 16) * 1024 + col0;
#pragma unroll
                for (int bj = 0; bj < 2; ++bj) { const u32x2 g = *(const u32x2*)(G8 + off + bj * HALF);
                    *(u32x4*)(P + off + bj * HALF) = pack8(ub4(g.x) * acc[ai][bj][m][0], ub4(g.y) * acc[ai][bj][m][1]); } }
    }
};
struct EpiGateB {
    static constexpr bool PERM = true, AFTER_DRAIN = false, HAS_MID = false;
    bf16_t* P; const unsigned char* Gc8;
    __device__ __forceinline__ void operator()(const f32x4 (&acc)[2][2][4][2], const Unit& u, int wr, int wc, int fr, int fq) const {
        const int col0 = u.pn * BM + wc * 32 + 8 * fq, row0 = u.pm * BM + wr * 64 + fr;
#pragma unroll
        for (int ai = 0; ai < 2; ++ai)
#pragma unroll
            for (int m = 0; m < 4; ++m) { const size_t off = (size_t)(row0 + ai * HALF + m * 16) * 1024 + col0;
#pragma unroll
                for (int bj = 0; bj < 2; ++bj) { const u32x4 p = *(const u32x4*)(P + off + bj * HALF); const u32x2 g = *(const u32x2*)(Gc8 + off + bj * HALF);
                    const f32x4 p0 = {bf_lo(p.x), bf_hi(p.x), bf_lo(p.y), bf_hi(p.y)}, p1 = {bf_lo(p.z), bf_hi(p.z), bf_lo(p.w), bf_hi(p.w)};
                    *(u32x4*)(P + off + bj * HALF) = pack8(p0 + ub4(g.x) * acc[ai][bj][m][0], p1 + ub4(g.y) * acc[ai][bj][m][1]); } }
    }
};
template <bool F32IN> struct EpiResid {
    static constexpr bool PERM = true, AFTER_DRAIN = false, HAS_MID = false;
    const float* xin; bf16_t* xb; float sc;
    __device__ __forceinline__ void operator()(const f32x4 (&acc)[2][2][4][2], const Unit& u, int wr, int wc, int fr, int fq) const {
        const int col0 = u.pn * BM + wc * 32 + 8 * fq, row0 = u.pm * BM + wr * 64 + fr;
#pragma unroll
        for (int ai = 0; ai < 2; ++ai) { f32x4 xv[4][2][2];
#pragma unroll
            for (int m = 0; m < 4; ++m)
#pragma unroll
                for (int bj = 0; bj < 2; ++bj) { const size_t o = (size_t)(row0 + ai * HALF + m * 16) * 1024 + col0 + bj * HALF;
                    if (F32IN) { xv[m][bj][0] = *(const f32x4*)(xin + o); xv[m][bj][1] = *(const f32x4*)(xin + o + 4); }
                    else { const u32x4 w0 = *(const u32x4*)(xb + o); xv[m][bj][0] = (f32x4){bf_lo(w0.x), bf_hi(w0.x), bf_lo(w0.y), bf_hi(w0.y)}; xv[m][bj][1] = (f32x4){bf_lo(w0.z), bf_hi(w0.z), bf_lo(w0.w), bf_hi(w0.w)}; } }
#pragma unroll
            for (int m = 0; m < 4; ++m)
#pragma unroll
                for (int bj = 0; bj < 2; ++bj) { const size_t o = (size_t)(row0 + ai * HALF + m * 16) * 1024 + col0 + bj * HALF;
                    *(u32x4*)(xb + o) = pack8(xv[m][bj][0] + acc[ai][bj][m][0] * sc, xv[m][bj][1] + acc[ai][bj][m][1] * sc); } }
    }
};
template <class RS, bool CS = false, bool F8OUT = false> struct EpiSwiGLU {
    static constexpr bool PERM = true, AFTER_DRAIN = false, HAS_MID = false;
    bf16_t* H; int ldh; RS rs; const float* cs; float f8scale;
    __device__ __forceinline__ void operator()(const f32x4 (&acc)[2][2][4][2], const Unit& u, int wr, int wc, int fr, int fq) const {
        const int col0 = u.pn * HALF + wc * 32 + 8 * fq, row0 = u.pm * BM + wr * 64 + fr;
        f32x4 cg[2], cu[2];
#pragma unroll
        for (int n = 0; n < 2; ++n) { if (CS) { cg[n] = *(const f32x4*)(cs + u.pn * BM + wc * 32 + 8 * fq + 4 * n); cu[n] = *(const f32x4*)(cs + u.pn * BM + HALF + wc * 32 + 8 * fq + 4 * n); }
                                      else { cg[n] = (f32x4){1.f, 1.f, 1.f, 1.f}; cu[n] = cg[n]; } }
        float s8[2][4];
#pragma unroll
        for (int ai = 0; ai < 2; ++ai)
#pragma unroll
            for (int m = 0; m < 4; ++m) s8[ai][m] = rs.get(row0 + ai * HALF + m * 16, fq);
#pragma unroll
        for (int ai = 0; ai < 2; ++ai)
#pragma unroll
            for (int m = 0; m < 4; ++m) { const int row = row0 + ai * HALF + m * 16; const float s = s8[ai][m]; f32x4 h[2];
#pragma unroll
                for (int n = 0; n < 2; ++n) { f32x4 g = acc[ai][0][m][n] * s, uu = acc[ai][1][m][n] * s; if (CS) { g = g * cg[n]; uu = uu * cu[n]; }
#pragma unroll
                    for (int i = 0; i < 4; ++i) h[n][i] = g[i] * uu[i] * sigmoidf_(g[i]); }
                if (F8OUT) { f32x4 q0 = h[0] * f8scale, q1 = h[1] * f8scale;
#pragma unroll
                    for (int i = 0; i < 4; ++i) { q0[i] = fminf(fmaxf(q0[i], -448.f), 448.f); q1[i] = fminf(fmaxf(q1[i], -448.f), 448.f); }
                    u32x2 w; w.x = pack4_fp8(q0[0], q0[1], q0[2], q0[3]); w.y = pack4_fp8(q1[0], q1[1], q1[2], q1[3]); *(u32x2*)((unsigned char*)H + (size_t)row * ldh + col0) = w; }
                else *(u32x4*)(H + (size_t)row * ldh + col0) = pack8(h[0], h[1]); }
    }
};
struct RowScaleP16X { const float* p; const float* xs;
    __device__ __forceinline__ float get(int row, int fq) const { return RowScaleP16{p}.get(row, fq) * xs[row]; } };
struct EpiPlainBf16 {
    static constexpr bool PERM = true, AFTER_DRAIN = false, HAS_MID = false;
    bf16_t* O; int ldc; float sc;
    __device__ __forceinline__ void operator()(const f32x4 (&acc)[2][2][4][2], const Unit& u, int wr, int wc, int fr, int fq) const {
        const int col0 = u.pn * BM + wc * 32 + 8 * fq, row0 = u.pm * BM + wr * 64 + fr;
#pragma unroll
        for (int ai = 0; ai < 2; ++ai)
#pragma unroll
            for (int m = 0; m < 4; ++m) { bf16_t* rowp = O + (size_t)(row0 + ai * HALF + m * 16) * ldc + col0;
#pragma unroll
                for (int bj = 0; bj < 2; ++bj) *(u32x4*)(rowp + bj * HALF) = pack8(acc[ai][bj][m][0] * sc, acc[ai][bj][m][1] * sc); }
    }
};

typedef int i32x4_t __attribute__((ext_vector_type(4)));
template <bool I8> __device__ __forceinline__ f32x4 mma16(const bf16x8 b, const bf16x8 a, const f32x4 c) {
    if constexpr (I8) return __builtin_bit_cast(f32x4, __builtin_amdgcn_mfma_i32_16x16x64_i8(__builtin_bit_cast(i32x4_t, b), __builtin_bit_cast(i32x4_t, a), __builtin_bit_cast(i32x4_t, c), 0, 0, 0));
    else return __builtin_amdgcn_mfma_f32_16x16x32_bf16(b, a, c, 0, 0, 0);
}
typedef int i32x8_t __attribute__((ext_vector_type(8)));
__device__ __forceinline__ f32x4 mma16_f8(const bf16x8 b0, const bf16x8 b1, const bf16x8 a0, const bf16x8 a1, const f32x4 c) {
    const i32x8_t vb = __builtin_shufflevector(__builtin_bit_cast(i32x4_t, b0), __builtin_bit_cast(i32x4_t, b1), 0, 1, 2, 3, 4, 5, 6, 7);
    const i32x8_t va = __builtin_shufflevector(__builtin_bit_cast(i32x4_t, a0), __builtin_bit_cast(i32x4_t, a1), 0, 1, 2, 3, 4, 5, 6, 7);
    return __builtin_amdgcn_mfma_scale_f32_16x16x128_f8f6f4(vb, va, c, 0, 0, 0, 0x7f7f7f7f, 0, 0x7f7f7f7f);
}
template <class Epi, class Sched, bool ALIGN_EPI = false, bool SP2 = false, bool I8 = false, bool F8 = false>
__device__ __forceinline__ void gemm_phase(PG8_LAS unsigned char* lds, const Gemm g, const Sched& S, const Epi& E, const int wid_in  ) {
    int lane_; asm volatile("v_mbcnt_lo_u32_b32 %0, -1, 0\n\tv_mbcnt_hi_u32_b32 %0, -1, %0" : "=v"(lane_));
    const int wid = wid_in, tid = wid * 64 + lane_, lane = lane_, wr = wid >> 2, wc = wid & 3, fr = lane & 15, fq = lane >> 4;
    const int K = g.K, nt = K / BK;
    unsigned voffA[2], voffB[2];
#pragma unroll
    for (int i = 0; i < 2; ++i) { int R, C; stage_rc(tid * 16 + i * 8192, R, C); const int Rb = Epi::PERM ? ((R & ~31) + perm32(R & 31)) : R;
        voffA[i] = (unsigned)(R * K + C) * 2u; voffB[i] = (unsigned)(Rb * K + C) * 2u; }
    const size_t kstep = (size_t)(BK * 2);
    const size_t hstep = (size_t)HALF * K * 2;
    const size_t tstep = 2 * hstep; const size_t rstep = (size_t)K * 2;
    const unsigned ldsw = (unsigned)wid * 1024u;
    const int aoff = lds_byte(wr * 64 + fr, fq * 8), boff = lds_byte(wc * 32 + fr, fq * 8);
#define PG8_SA(b, h) (((b) * 2 + (h)) * HTB)
#define PG8_SB(b, h) ((4 + (b) * 2 + (h)) * HTB)
#define PG8_STAGE(bufoff, gbase, voff) do { _Pragma("unroll") for (int _i = 0; _i < 2; ++_i) \
        __builtin_amdgcn_global_load_lds((const unsigned*)((const char*)(gbase) + (voff)[_i]), (PG8_LAS unsigned*)(lds + (bufoff) + ldsw + _i * 8192), 16, 0, 0); } while (0)
#define PG8_LDA(dst, b, h) do { if constexpr (F8) { _Pragma("unroll") for (int m = 0; m < 4; ++m) { const i32x4_t lo_ = *(const PG8_LAS i32x4_t*)(lds + PG8_SA(b, h) + aoff + m * 2048), hi_ = *(const PG8_LAS i32x4_t*)(lds + PG8_SA(b, h) + aoff + m * 2048 + 1024); \
        dst##8[m] = __builtin_shufflevector(lo_, hi_, 0, 1, 2, 3, 4, 5, 6, 7); } } else { _Pragma("unroll") for (int m = 0; m < 4; ++m) _Pragma("unroll") for (int k = 0; k < 2; ++k) dst[m][k] = *(const PG8_LAS bf16x8*)(lds + PG8_SA(b, h) + aoff + m * 2048 + k * 1024); } } while (0)
#define PG8_LDB(dst, b, h) do { if constexpr (F8) { _Pragma("unroll") for (int n = 0; n < 2; ++n) { const i32x4_t lo_ = *(const PG8_LAS i32x4_t*)(lds + PG8_SB(b, h) + boff + n * 2048), hi_ = *(const PG8_LAS i32x4_t*)(lds + PG8_SB(b, h) + boff + n * 2048 + 1024); \
        dst##8[n] = __builtin_shufflevector(lo_, hi_, 0, 1, 2, 3, 4, 5, 6, 7); } } else { _Pragma("unroll") for (int n = 0; n < 2; ++n) _Pragma("unroll") for (int k = 0; k < 2; ++k) dst[n][k] = *(const PG8_LAS bf16x8*)(lds + PG8_SB(b, h) + boff + n * 2048 + k * 1024); } } while (0)
#define PG8_MMA(ai, bj, At, Bt) do { __builtin_amdgcn_s_setprio(1); if constexpr (F8) { _Pragma("unroll") for (int m = 0; m < 4; ++m) _Pragma("unroll") for (int n = 0; n < 2; ++n) \
        asm volatile("v_mfma_scale_f32_16x16x128_f8f6f4 %0, %1, %2, %0, %3, %3 op_sel_hi:[0,0,0]" : "+v"(acc[ai][bj][m][n]) : "v"(Bt##8[n]), "v"(At##8[m]), "v"(f8one)); } else { _Pragma("unroll") for (int m = 0; m < 4; ++m) _Pragma("unroll") for (int n = 0; n < 2; ++n) _Pragma("unroll") for (int k = 0; k < 2; ++k) \
        acc[ai][bj][m][n] = mma16<I8>(Bt[n][k], At[m][k], acc[ai][bj][m][n]); } __builtin_amdgcn_s_setprio(0); } while (0)
#define PG8_WAIT_V(n) asm volatile("s_waitcnt vmcnt(" #n ")" ::: "memory")
#define PG8_WAIT_L(n) asm volatile("s_waitcnt lgkmcnt(" #n ")" ::: "memory")
#define PG8_BAR __builtin_amdgcn_s_barrier()
#define PG8_SCHED __builtin_amdgcn_sched_barrier(0)
    Unit cur, nxt; int ui = 0;
    if (!S.next(0, cur)) return;
    f32x4 acc[2][2][4][2];
#pragma unroll
    for (int a = 0; a < 2; ++a)
#pragma unroll
        for (int b = 0; b < 2; ++b)
#pragma unroll
            for (int m = 0; m < 4; ++m)
#pragma unroll
                for (int n = 0; n < 2; ++n) acc[a][b][m][n] = (f32x4){0.f, 0.f, 0.f, 0.f};
    const int f8one = 0x7f7f7f7f;
    bf16x8 At[4][2], B0[2][2], B1[2][2]; i32x8_t At8[4], B08[2], B18[2];
    const char* cA = (const char*)(cur.seg ? g.A2 : g.A) + (size_t)cur.pm * tstep; const char* cB = (const char*)(cur.seg ? g.Bt2 : g.Bt) + (size_t)cur.pn * tstep + (size_t)cur.be * rstep;
    S.a_ready(cur);
    if constexpr (SP2) {
        PG8_STAGE(PG8_SB(0, 0), cB, voffB); PG8_STAGE(PG8_SB(0, 1), cB + hstep, voffB); PG8_STAGE(PG8_SA(0, 0), cA, voffA); PG8_STAGE(PG8_SA(0, 1), cA + hstep, voffA);
        if (wr == 1) PG8_BAR;
        PG8_WAIT_V(2); PG8_BAR;
        PG8_STAGE(PG8_SB(1, 0), cB + kstep, voffB); PG8_STAGE(PG8_SA(1, 0), cA + kstep, voffA); PG8_STAGE(PG8_SB(1, 1), cB + hstep + kstep, voffB);
        PG8_WAIT_V(6); PG8_BAR;
    } else {
        PG8_STAGE(PG8_SB(0, 0), cB, voffB); PG8_STAGE(PG8_SA(0, 0), cA, voffA); PG8_STAGE(PG8_SB(0, 1), cB + hstep, voffB); PG8_STAGE(PG8_SA(0, 1), cA + hstep, voffA);
        if (wr == 1) PG8_BAR;
        PG8_WAIT_V(4); PG8_BAR;
        PG8_STAGE(PG8_SB(1, 0), cB + kstep, voffB); PG8_STAGE(PG8_SA(1, 0), cA + kstep, voffA); PG8_STAGE(PG8_SB(1, 1), cB + hstep + kstep, voffB);
        PG8_WAIT_V(6); PG8_BAR;
    }
    for (;;) {
        const bool has_next = S.next(ui + 1, nxt);
        const char* nA = has_next ? (const char*)(nxt.seg ? g.A2 : g.A) + (size_t)nxt.pm * tstep : cA; const char* nB = has_next ? (const char*)(nxt.seg ? g.Bt2 : g.Bt) + (size_t)nxt.pn * tstep + (size_t)nxt.be * rstep : cB;
        for (int t = 0; t < nt; t += 2) {
            const bool last = (t == nt - 2);
            const char* a1 = cA + (size_t)(t + 1) * kstep;
            const char* a2 = last ? nA : cA + (size_t)(t + 2) * kstep; const char* b2 = last ? nB : cB + (size_t)(t + 2) * kstep;
            const char* a3 = a2 + kstep; const char* b3 = b2 + kstep;
            if (last && has_next) S.a_ready(nxt);
            if constexpr (SP2) {
            PG8_LDB(B0, 0, 0); PG8_LDB(B1, 0, 1); PG8_SCHED; PG8_LDA(At, 0, 0); PG8_STAGE(PG8_SA(1, 1), a1 + hstep, voffA);
            PG8_WAIT_V(8); PG8_WAIT_L(0); PG8_BAR; PG8_MMA(0, 0, At, B0); PG8_MMA(0, 1, At, B1); PG8_BAR; PG8_SCHED;
            PG8_LDA(At, 0, 1); PG8_STAGE(PG8_SB(0, 0), b2, voffB); PG8_STAGE(PG8_SB(0, 1), b2 + hstep, voffB); PG8_STAGE(PG8_SA(0, 0), a2, voffA);
            PG8_WAIT_V(8); PG8_WAIT_L(0); PG8_BAR; PG8_MMA(1, 0, At, B0); PG8_MMA(1, 1, At, B1); PG8_BAR; PG8_SCHED;
            PG8_LDB(B0, 1, 0); PG8_LDB(B1, 1, 1); PG8_SCHED; PG8_LDA(At, 1, 0); PG8_STAGE(PG8_SA(0, 1), a2 + hstep, voffA);
            PG8_WAIT_V(8); PG8_WAIT_L(0); PG8_BAR; PG8_MMA(0, 0, At, B0); PG8_MMA(0, 1, At, B1); PG8_BAR; PG8_SCHED;
            PG8_LDA(At, 1, 1); PG8_STAGE(PG8_SB(1, 0), b3, voffB); PG8_STAGE(PG8_SB(1, 1), b3 + hstep, voffB); PG8_STAGE(PG8_SA(1, 0), a3, voffA);
            PG8_WAIT_V(8); PG8_WAIT_L(0); PG8_BAR; PG8_MMA(1, 0, At, B0); PG8_MMA(1, 1, At, B1); PG8_BAR; PG8_SCHED;
            } else {
            PG8_LDB(B0, 0, 0); PG8_SCHED; PG8_LDA(At, 0, 0); PG8_STAGE(PG8_SA(1, 1), a1 + hstep, voffA);
            PG8_WAIT_L(8); PG8_BAR; PG8_WAIT_L(0); PG8_MMA(0, 0, At, B0); PG8_BAR; PG8_SCHED;
            PG8_LDB(B1, 0, 1); PG8_STAGE(PG8_SB(0, 0), b2, voffB);
            PG8_BAR; PG8_WAIT_L(0); PG8_MMA(0, 1, At, B1); PG8_BAR;
            PG8_LDA(At, 0, 1); PG8_STAGE(PG8_SA(0, 0), a2, voffA);
            PG8_BAR; PG8_WAIT_L(0); PG8_MMA(1, 0, At, B0); PG8_BAR; PG8_SCHED;
            PG8_STAGE(PG8_SB(0, 1), b2 + hstep, voffB);
            PG8_WAIT_V(6); PG8_BAR; PG8_MMA(1, 1, At, B1); PG8_BAR;
            PG8_LDB(B0, 1, 0); PG8_SCHED; PG8_LDA(At, 1, 0); PG8_STAGE(PG8_SA(0, 1), a2 + hstep, voffA);
            PG8_WAIT_L(8); PG8_BAR; PG8_WAIT_L(0); PG8_MMA(0, 0, At, B0); PG8_BAR; PG8_SCHED;
            PG8_LDB(B1, 1, 1); PG8_STAGE(PG8_SB(1, 0), b3, voffB);
            PG8_BAR; PG8_WAIT_L(0); PG8_MMA(0, 1, At, B1); PG8_BAR;
            PG8_LDA(At, 1, 1); PG8_STAGE(PG8_SA(1, 0), a3, voffA);
            PG8_BAR; PG8_WAIT_L(0); PG8_MMA(1, 0, At, B0); PG8_BAR; PG8_SCHED;
            PG8_STAGE(PG8_SB(1, 1), b3 + hstep, voffB);
            PG8_WAIT_V(6); PG8_BAR; PG8_MMA(1, 1, At, B1); PG8_BAR;
            }
        }
        if constexpr (ALIGN_EPI) { if (wr == 0) PG8_BAR; }
        if constexpr (F8) asm volatile("s_nop 15\n\ts_nop 15" ::: "memory");
        if constexpr (I8) {
#pragma unroll
            for (int a = 0; a < 2; ++a)
#pragma unroll
                for (int b = 0; b < 2; ++b)
#pragma unroll
                    for (int m = 0; m < 4; ++m)
#pragma unroll
                        for (int n = 0; n < 2; ++n) { const i32x4_t iv = __builtin_bit_cast(i32x4_t, acc[a][b][m][n]); acc[a][b][m][n] = (f32x4){(float)iv[0], (float)iv[1], (float)iv[2], (float)iv[3]}; } }
        bool carry = false;
        if constexpr (Epi::HAS_MID) { if (cur.seg == 0) { E.mid(acc, cur, wr, wc, fr, fq); carry = true; } }
        if constexpr (!Epi::AFTER_DRAIN) { if (!carry) { E(acc, cur, wr, wc, fr, fq); S.done(cur); } }
        if (!has_next) break;
        if (!carry)
#pragma unroll
        for (int a = 0; a < 2; ++a)
#pragma unroll
            for (int b = 0; b < 2; ++b)
#pragma unroll
                for (int m = 0; m < 4; ++m)
#pragma unroll
                    for (int n = 0; n < 2; ++n) acc[a][b][m][n] = (f32x4){0.f, 0.f, 0.f, 0.f};
        cur = nxt; cA = nA; cB = nB; ++ui;
        if constexpr (ALIGN_EPI) { if (wr == 1) PG8_BAR; }
    }
    PG8_WAIT_V(0);
    if constexpr (!ALIGN_EPI) { if (wr == 0) PG8_BAR; }
    PG8_BAR;
    if constexpr (Epi::AFTER_DRAIN) { E.fused(acc, cur, wr, wc, fr, fq, lds, wid, lane); S.done(cur); }
#undef PG8_SA
#undef PG8_SB
#undef PG8_STAGE
#undef PG8_LDA
#undef PG8_LDB
#undef PG8_MMA
#undef PG8_WAIT_V
#undef PG8_WAIT_L
#undef PG8_BAR
#undef PG8_SCHED
}
}

namespace dattn {
using bf16 = unsigned short;
using bf16x8 = __attribute__((ext_vector_type(8))) short;
using s16x4 = __attribute__((ext_vector_type(4))) short;
using f32x16 = __attribute__((ext_vector_type(16))) float;
using f32x4 = __attribute__((ext_vector_type(4))) float;
using u32x4 = __attribute__((ext_vector_type(4))) unsigned;
constexpr int SEQ = 16384, PITCH = 1024, KVBLK = 64, QBLK = 32, UROWS = 128;
constexpr int SHM_V = KVBLK * 128 * 2, SHM_K = KVBLK * 128 * 2;
constexpr int XPITCH = 132;
constexpr int L_V = 0, L_K = 2 * SHM_V, L_XCH = 0, XCH_WAVE = 32 * XPITCH * 4, L_WS = 4 * XCH_WAVE, L_TAB = L_WS + 8 * 256, LDS_BYTES = L_TAB + 384 * 4;
static_assert(L_WS >= 2 * SHM_V + 2 * SHM_K, "exchange region overlays the K/V buffers");
constexpr float LOG2E = 1.4426950408889634f;
constexpr float THR = 8.f;
__constant__ unsigned char BKT[128] = {0, 1, 2, 3, 4, 5, 6, 7, 8, 9, 10, 11, 12, 13, 14, 15, 16, 16, 16, 17, 17, 18, 18, 18, 19, 19, 19, 20, 20, 20, 20, 21, 21, 21, 21, 22, 22, 22, 22, 22, 23, 23, 23, 23, 23, 23, 24, 24, 24, 24, 24, 24,
    25, 25, 25, 25, 25, 25, 25, 26, 26, 26, 26, 26, 26, 26, 26, 27, 27, 27, 27, 27, 27, 27, 27, 27, 27, 28, 28, 28, 28, 28, 28, 28, 28, 28, 28, 29, 29, 29, 29, 29, 29, 29, 29, 29, 29, 29, 29,
    30, 30, 30, 30, 30, 30, 30, 30, 30, 30, 30, 30, 30, 30, 31, 31, 31, 31, 31, 31, 31, 31, 31, 31, 31, 31, 31, 31, 31};
#define KSWZ(row, colB) ((row) * 256 + ((colB) ^ (((row) & 7) << 4)))
#define SBAR() __builtin_amdgcn_sched_barrier(0)
__device__ __forceinline__ int crow(int r, int hi) { return (r & 3) + 8 * (r >> 2) + 4 * hi; }
__device__ __forceinline__ unsigned cvtpk(float lo, float hi) { unsigned r; asm volatile("v_cvt_pk_bf16_f32 %0, %1, %2" : "=v"(r) : "v"(lo), "v"(hi)); return r; }

__device__ __forceinline__ void softmaxY(f32x16& p0, f32x16& p1, float& m_reg, float& l_reg, f32x16& negm, f32x16* o, float* al_l, int r32, int hi, bool band, bool first, const float* tl,
                                         bf16x8& pa0, bf16x8& pa1, bf16x8& pa2, bf16x8& pa3) {
  if (band) {
#pragma unroll
    for (int r = 0; r < 16; ++r) { const int c = (r & 3) + 8 * (r >> 2); p0[r] += tl[c]; p1[r] += tl[32 + c]; }
  }
  float pa = fmaxf(fmaxf(p0[0], p0[1]), p1[0]), pb = fmaxf(fmaxf(p0[2], p0[3]), p1[1]); pa = fmaxf(fmaxf(pa, p1[2]), p1[3]);
#pragma unroll
  for (int r = 4; r < 16; r += 4) { pa = fmaxf(fmaxf(pa, p0[r]), p0[r + 1]); pb = fmaxf(fmaxf(pb, p0[r + 2]), p0[r + 3]); pa = fmaxf(fmaxf(pa, p1[r]), p1[r + 1]); pb = fmaxf(fmaxf(pb, p1[r + 2]), p1[r + 3]); }
  float pmax = fmaxf(pa, pb);
  { auto rr = __builtin_amdgcn_permlane32_swap(__float_as_uint(pmax), __float_as_uint(pmax), false, false);
    pmax = fmaxf(__uint_as_float(rr[0]), __uint_as_float(rr[1])); }
  if (__builtin_expect(first || !__all(pmax <= THR), 0)) {
    const float dl = first ? pmax : fmaxf(pmax, 0.f), alpha = __builtin_amdgcn_exp2f(-dl); m_reg += dl; l_reg *= alpha;
#pragma unroll
    for (int r = 0; r < 16; ++r) { p0[r] -= dl; p1[r] -= dl; negm[r] = -m_reg; }
    if (hi == 0) al_l[r32] = alpha;
    asm volatile("s_waitcnt lgkmcnt(0)" ::: "memory");
#pragma unroll
    for (int d = 0; d < 4; ++d)
#pragma unroll
      for (int r = 0; r < 16; ++r) o[d][r] *= al_l[crow(r, hi)];
  }
#pragma unroll
  for (int r = 0; r < 16; ++r) { p0[r] = __builtin_amdgcn_exp2f(p0[r]); p1[r] = __builtin_amdgcn_exp2f(p1[r]); }
  float ps = 0.f, ps2 = 0.f;
#pragma unroll
  for (int r = 0; r < 16; ++r) { ps += p0[r]; ps2 += p1[r]; }
  ps += ps2;
  { auto rr = __builtin_amdgcn_permlane32_swap(__float_as_uint(ps), __float_as_uint(ps), false, false);
    ps = __uint_as_float(rr[0]) + __uint_as_float(rr[1]); }
  l_reg += ps;
#define PK4(P, BASE, OUT) do { u32x4 w = {cvtpk(P[BASE + 0], P[BASE + 1]), cvtpk(P[BASE + 2], P[BASE + 3]), cvtpk(P[BASE + 4], P[BASE + 5]), cvtpk(P[BASE + 6], P[BASE + 7])}; \
    OUT = *reinterpret_cast<bf16x8*>(&w); } while (0)
  PK4(p0, 0, pa0); PK4(p0, 8, pa1); PK4(p1, 0, pa2); PK4(p1, 8, pa3);
#undef PK4
}
__device__ __forceinline__ void qkt(f32x16& p0, f32x16& p1, const char* Ks, const bf16x8* qr, int r32, int hi, int map) {
  p0 = f32x16{}; p1 = f32x16{};
#pragma unroll
  for (int d0 = 0; d0 < 4; ++d0) { const int cb = (map * 64 + d0 * 16 + hi * 8) * 2;
    const bf16x8 b0 = *reinterpret_cast<const bf16x8*>(Ks + KSWZ(r32, cb));
    const bf16x8 b1 = *reinterpret_cast<const bf16x8*>(Ks + KSWZ(32 + r32, cb));
    p0 = __builtin_amdgcn_mfma_f32_32x32x16_bf16(b0, qr[d0], p0, 0, 0, 0);
    p1 = __builtin_amdgcn_mfma_f32_32x32x16_bf16(b1, qr[d0], p1, 0, 0, 0); }
}
__device__ __forceinline__ int v_st(int k, int c) { const int kk = (k & ~0xC) | ((k & 4) << 1) | ((k & 8) >> 1); return ((kk >> 3) * 4 + (c >> 5)) * 512 + ((kk & 7) * 32 + (c & 31)) * 2; }
__device__ __forceinline__ int v_rd_base(int lane) { return ((lane & 3) << 3) | (((lane >> 2) & 3) << 6) | (((lane >> 4) & 1) << 5) | (((lane >> 5) & 1) << 8); }
constexpr int v_rd_off(int d0, int ks, int half) { return d0 * 512 + ks * 4096 + half * 2048; }
typedef short v4i16_t __attribute__((ext_vector_type(4)));
template <int OFF> __device__ __forceinline__ s16x4 tr_read(int vb) {
  return __builtin_bit_cast(s16x4, __builtin_amdgcn_ds_read_tr16_b64_v4i16((__attribute__((address_space(3))) v4i16_t*)(size_t)(unsigned)(vb + OFF)));
}
template <int D0> __device__ __forceinline__ void pv_one(f32x16& od, int vb, bf16x8 pa0, bf16x8 pa1, bf16x8 pa2, bf16x8 pa3) {
  const s16x4 l0 = tr_read<v_rd_off(D0, 0, 0)>(vb), h0 = tr_read<v_rd_off(D0, 0, 1)>(vb), l1 = tr_read<v_rd_off(D0, 1, 0)>(vb), h1 = tr_read<v_rd_off(D0, 1, 1)>(vb);
  const s16x4 l2 = tr_read<v_rd_off(D0, 2, 0)>(vb), h2 = tr_read<v_rd_off(D0, 2, 1)>(vb), l3 = tr_read<v_rd_off(D0, 3, 0)>(vb), h3 = tr_read<v_rd_off(D0, 3, 1)>(vb);
#define PK(L, H) (bf16x8){L[0], L[1], L[2], L[3], H[0], H[1], H[2], H[3]}
  od = __builtin_amdgcn_mfma_f32_32x32x16_bf16(pa0, PK(l0, h0), od, 0, 0, 0);
  od = __builtin_amdgcn_mfma_f32_32x32x16_bf16(pa1, PK(l1, h1), od, 0, 0, 0);
  od = __builtin_amdgcn_mfma_f32_32x32x16_bf16(pa2, PK(l2, h2), od, 0, 0, 0);
  od = __builtin_amdgcn_mfma_f32_32x32x16_bf16(pa3, PK(l3, h3), od, 0, 0, 0);
#undef PK
}
__device__ __forceinline__ void pv_d0(f32x16* o, int vb, bf16x8 pa0, bf16x8 pa1, bf16x8 pa2, bf16x8 pa3) {
  pv_one<0>(o[0], vb, pa0, pa1, pa2, pa3); pv_one<1>(o[1], vb, pa0, pa1, pa2, pa3); pv_one<2>(o[2], vb, pa0, pa1, pa2, pa3); pv_one<3>(o[3], vb, pa0, pa1, pa2, pa3);
}

template <bool QK, bool PV>
__device__ __forceinline__ void xphase(f32x16& s0, f32x16& s1, const f32x16& negm, f32x16* o, const char* Ks, int vb, const bf16x8* qr, bf16x8 pa0, bf16x8 pa1, bf16x8 pa2, bf16x8 pa3, int r32, int hi, int map) {
  constexpr int N0 = QK ? 0 : 8, N1 = PV ? 24 : 8, AHEAD = 2;
  bf16x8 f[4];
#define XLD(n) do { if ((n) < 8) { const int d0_ = (n) >> 1, hf_ = (n) & 1; \
      f[(n) & 3] = *reinterpret_cast<const bf16x8*>(Ks + KSWZ(hf_ * 32 + r32, (map * 64 + d0_ * 16 + hi * 8) * 2)); } \
    else { const int m_ = (n) - 8, D0_ = m_ >> 2, ks_ = m_ & 3; \
      const s16x4 lo_ = __builtin_bit_cast(s16x4, __builtin_amdgcn_ds_read_tr16_b64_v4i16((__attribute__((address_space(3))) v4i16_t*)(size_t)(unsigned)(vb + D0_ * 512 + ks_ * 4096))); \
      const s16x4 hi2_ = __builtin_bit_cast(s16x4, __builtin_amdgcn_ds_read_tr16_b64_v4i16((__attribute__((address_space(3))) v4i16_t*)(size_t)(unsigned)(vb + D0_ * 512 + ks_ * 4096 + 2048))); \
      f[(n) & 3] = (bf16x8){lo_[0], lo_[1], lo_[2], lo_[3], hi2_[0], hi2_[1], hi2_[2], hi2_[3]}; } } while (0)
#pragma unroll
  for (int n = N0; n < N0 + AHEAD; ++n) XLD(n);
#pragma unroll
  for (int n = N0; n < N1; ++n) {
    if (n + AHEAD < N1) XLD(n + AHEAD);
    SBAR();
    if (n < 8) { if (n & 1) s1 = __builtin_amdgcn_mfma_f32_32x32x16_bf16(f[n & 3], qr[n >> 1], n == 1 ? negm : s1, 0, 0, 0); else s0 = __builtin_amdgcn_mfma_f32_32x32x16_bf16(f[n & 3], qr[n >> 1], n == 0 ? negm : s0, 0, 0, 0); }
    else { const int m_ = n - 8, D0_ = m_ >> 2, ks_ = m_ & 3; const bf16x8 pa_ = ks_ == 0 ? pa0 : ks_ == 1 ? pa1 : ks_ == 2 ? pa2 : pa3;
      o[D0_] = __builtin_amdgcn_mfma_f32_32x32x16_bf16(pa_, f[n & 3], o[D0_], 0, 0, 0); }
    SBAR();
  }
#undef XLD
}
__device__ __forceinline__ void glds16s(unsigned voff, const void* sbase, unsigned lds_dst) {
  unsigned keep;
  asm volatile("s_mov_b32 %0, m0\n\ts_mov_b32 m0, %3\n\ts_nop 0\n\tglobal_load_lds_dwordx4 %1, %2\n\ts_mov_b32 m0, %0" : "=&s"(keep) : "v"(voff), "s"(sbase), "s"(lds_dst) : "memory");
}
#define BAR_L()  asm volatile("s_waitcnt lgkmcnt(0)\n\ts_barrier" ::: "memory")
#define BAR_VL() asm volatile("s_waitcnt vmcnt(0) lgkmcnt(0)\n\ts_barrier" ::: "memory")
__device__ __forceinline__ void attn_unit(int b, int h, int qb, const bf16* Zq, const bf16* __restrict__ Zk, const bf16* __restrict__ Zv, bf16* Oa,
                                          const float* __restrict__ rel_bias, const float* par, int layer, const float* __restrict__ gsub, char* lds, const int wid_in) {
  int lane_; asm volatile("v_mbcnt_lo_u32_b32 %0, -1, 0\n\tv_mbcnt_hi_u32_b32 %0, -1, %0" : "=v"(lane_));
  const int wid = wid_in, lane = lane_, tid = wid * 64 + lane, r32 = lane & 31, hi = lane >> 5;
  const int map = wid >> 2, g = wid & 3; const bool grpB = (wid >= 4);
  const long rowbase = (long)b * SEQ; const int q0 = qb * UROWS, NT = 2 * qb + 2;
  char* V_lds = lds + L_V; char* K_lds = lds + L_K;
  float* tab = (float*)(lds + L_TAB);
  BAR_L();
  for (int i = tid; i < 384; i += 512) { const int dist = 255 - i; float v;
    if (dist < 0) v = -INFINITY; else if (dist >= 113) v = 0.f; else v = (rel_bias[(int)BKT[dist] * 8 + h] - rel_bias[31 * 8 + h]) * LOG2E;
    tab[i] = v; }
  const bf16* Kh = Zk + rowbase * PITCH + h * 128; const bf16* Vh = Zv + rowbase * PITCH + h * 128;
  unsigned kof0, kof1, vof0, vof1;
  { const int row0 = 8 * wid + (lane >> 4), row1 = row0 + 4, c0 = (lane & 15) ^ (row0 & 7), c1 = (lane & 15) ^ (row1 & 7);
    kof0 = (unsigned)(row0 * PITCH + c0 * 8) * 2u; kof1 = (unsigned)(row1 * PITCH + c1 * 8) * 2u;
    const int sub0 = 4 * wid + (lane >> 5), sub1 = sub0 + 2, klo = (lane & 31) >> 2, cin = 8 * (lane & 3);
    const int kk0 = (sub0 >> 2) * 8 + klo, kk1 = (sub1 >> 2) * 8 + klo;
    const int k0 = kk0, k1 = kk1;
    vof0 = (unsigned)(k0 * PITCH + (sub0 & 3) * 32 + cin) * 2u; vof1 = (unsigned)(k1 * PITCH + (sub1 & 3) * 32 + cin) * 2u; }
  const unsigned lds0 = (unsigned)(uintptr_t)lds;
  const unsigned kdst = (unsigned)__builtin_amdgcn_readfirstlane((int)(lds0 + L_K + 2 * wid * 1024)), vdst = (unsigned)__builtin_amdgcn_readfirstlane((int)(lds0 + L_V + 2 * wid * 1024));
#define DMA_K(t, sl) do { const bf16* kb_ = Kh + (long)(t) * KVBLK * PITCH; glds16s(kof0, kb_, kdst + (unsigned)(sl) * SHM_K); glds16s(kof1, kb_, kdst + (unsigned)(sl) * SHM_K + 1024u); } while (0)
#define DMA_V(t, sl) do { const bf16* vb_ = Vh + (long)(t) * KVBLK * PITCH; glds16s(vof0, vb_, vdst + (unsigned)(sl) * SHM_V); glds16s(vof1, vb_, vdst + (unsigned)(sl) * SHM_V + 1024u); } while (0)
#define ISSUE2(j) do { const int j_ = (j); if (j_ + 2 < NT) DMA_K(j_ + 2, j_ & 1); if (j_ + 1 < NT) DMA_V(j_ + 1, (j_ + 1) & 1); } while (0)
  DMA_K(0, 0); DMA_K(1, 1); DMA_V(0, 0);
  float m_reg = 0.f, l_reg = 0.f; f32x16 o[4] = {}; f32x16 negm = {}; bf16x8 qr[4];
  const bf16* Qw = Zq + (rowbase + q0 + g * QBLK + r32) * PITCH + h * 128 + map * 64 + hi * 8;
#pragma unroll
  for (int d0 = 0; d0 < 4; ++d0) qr[d0] = *reinterpret_cast<const bf16x8*>(Qw + d0 * 16);
  const int vb0 = (int)(uintptr_t)V_lds + v_rd_base(lane);
  const int qpos = q0 + g * QBLK + r32;
  const float* tl0 = tab + (255 - qpos + 4 * hi);
#define BAND(j) ((j) >= NT - 4)
#define AL_L() ((float*)(lds + L_WS) + wid * 64 + 32)
  f32x16 pS0, pS1; bf16x8 pa0 = {}, pa1 = {}, pa2 = {}, pa3 = {};
  BAR_VL();
  xphase<true, false>(pS0, pS1, negm, o, K_lds, vb0, qr, pa0, pa1, pa2, pa3, r32, hi, map);
  BAR_L();
  if (grpB) BAR_L();
#pragma unroll 1
  for (int i = 0; i < NT - 1; ++i) {
    if (grpB) ISSUE2(i);
    softmaxY(pS0, pS1, m_reg, l_reg, negm, o, AL_L(), r32, hi, BAND(i), i == 0, tl0 + i * KVBLK, pa0, pa1, pa2, pa3);
    if (grpB) BAR_L(); else BAR_VL();
    if (!grpB) ISSUE2(i);
    xphase<true, true>(pS0, pS1, negm, o, K_lds + ((i + 1) & 1) * SHM_K, vb0 + (i & 1) * SHM_V, qr, pa0, pa1, pa2, pa3, r32, hi, map);
    if (grpB) BAR_VL(); else BAR_L();
  }
  if (grpB) ISSUE2(NT - 1);
  softmaxY(pS0, pS1, m_reg, l_reg, negm, o, AL_L(), r32, hi, true, false, tl0 + (NT - 1) * KVBLK, pa0, pa1, pa2, pa3);
  if (grpB) BAR_L(); else BAR_VL();
  xphase<false, true>(pS0, pS1, negm, o, K_lds, vb0 + SHM_V, qr, pa0, pa1, pa2, pa3, r32, hi, map);
  if (!grpB) BAR_L();
  float* li_l = (float*)(lds + L_WS) + wid * 64;
  float lam, gmul; { const __attribute__((address_space(1))) float* pp = (const __attribute__((address_space(1))) float*)par; int l2 = layer; asm volatile("" : "+s"(pp), "+s"(l2)); lam = pp[l2]; gmul = 1.f - ((l2 == 0) ? 0.2f : (0.8f - 0.6f * 0.7408182206817179f)); }
  if (hi == 0) li_l[r32] = l_reg; asm volatile("s_waitcnt lgkmcnt(0)" ::: "memory");
  float rli[16];
#pragma unroll
  for (int r = 0; r < 16; ++r) rli[r] = __builtin_amdgcn_rcpf(li_l[crow(r, hi)]);
  float* X = (float*)(lds + L_XCH + g * XCH_WAVE);
  BAR_L();
  if (map == 1) {
#pragma unroll
    for (int d0 = 0; d0 < 4; ++d0)
#pragma unroll
      for (int r = 0; r < 16; ++r) X[crow(r, hi) * XPITCH + d0 * 32 + r32] = o[d0][r] * rli[r];
  }
  BAR_L();
  if (map == 0) {
#pragma unroll
    for (int d0 = 0; d0 < 4; ++d0)
#pragma unroll
      for (int r = 0; r < 16; ++r) { float* xp = &X[crow(r, hi) * XPITCH + d0 * 32 + r32]; *xp = o[d0][r] * rli[r] - lam * (*xp); }
    asm volatile("s_waitcnt lgkmcnt(0)" ::: "memory");
    const f32x4* xr = (const f32x4*)(X + r32 * XPITCH + hi * 64);
    f32x4 v[16]; float ss = 0.f;
#pragma unroll
    for (int i = 0; i < 16; ++i) { v[i] = xr[i]; ss += (v[i][0] * v[i][0] + v[i][1] * v[i][1]) + (v[i][2] * v[i][2] + v[i][3] * v[i][3]); }
    { auto rr = __builtin_amdgcn_permlane32_swap(__float_as_uint(ss), __float_as_uint(ss), false, false); ss = __uint_as_float(rr[0]) + __uint_as_float(rr[1]); }
    const float rs = __builtin_amdgcn_rsqf(ss * (1.0f / 128.0f) + 1e-6f) * gmul;
    bf16* op = Oa + (rowbase + q0 + g * QBLK + r32) * PITCH + h * 128 + hi * 64;
    const f32x4* gp = (const f32x4*)(gsub + hi * 64);
#pragma unroll
    for (int i = 0; i < 16; i += 2) { const f32x4 g0 = gp[i], g1 = gp[i + 1]; u32x4 w;
      w.x = cvtpk(v[i][0] * rs * g0[0], v[i][1] * rs * g0[1]); w.y = cvtpk(v[i][2] * rs * g0[2], v[i][3] * rs * g0[3]);
      w.z = cvtpk(v[i + 1][0] * rs * g1[0], v[i + 1][1] * rs * g1[1]); w.w = cvtpk(v[i + 1][2] * rs * g1[2], v[i + 1][3] * rs * g1[3]);
      *(u32x4*)(op + i * 4) = w; }
  }
#undef ISSUE2
#undef DMA_K
#undef DMA_V
#undef AL_L
#undef BAND
}

constexpr int L3_K = 0, L3_V = 3 * SHM_K, L3_WS = 3 * SHM_K + 3 * SHM_V, L3_TAB = L3_WS + 8 * 256, L3_FLG = L3_TAB + 384 * 4, LDS3_BYTES = L3_FLG + 32;
constexpr float FAST_B = 96.f;
static_assert(L3_WS >= 4 * XCH_WAVE, "exchange region overlays the K/V rings");
#define PIN(x) asm volatile("" : "+v"(x))
#define MFMA32(a, b, c) __builtin_amdgcn_mfma_f32_32x32x16_bf16(a, b, c, 0, 0, 0)
#define MX3(a, b, c) __builtin_fmaxf(__builtin_fmaxf((a), (b)), (c))
#define EX2(v) __builtin_amdgcn_exp2f(v)
__device__ __forceinline__ void attn_unit3(int b, int h, int qb, const bf16* Zq, const bf16* __restrict__ Zk, const bf16* __restrict__ Zv, bf16* Oa,
                                           const float* __restrict__ rel_bias, const float* par, int layer, const float* __restrict__ gsub, char* lds, const int wid_in, const unsigned* kmaxw) {
  int lane_; asm volatile("v_mbcnt_lo_u32_b32 %0, -1, 0\n\tv_mbcnt_hi_u32_b32 %0, -1, %0" : "=v"(lane_));
  const int wid = wid_in, lane = lane_, tid = wid * 64 + lane, r32 = lane & 31, hi = lane >> 5;
  const int map = wid >> 2, g = wid & 3;
  const long rowbase = (long)b * SEQ; const int q0 = qb * UROWS, NT = 2 * qb + 2;
  char* K_lds = lds + L3_K; char* V_lds = lds + L3_V;
  float* tab = (float*)(lds + L3_TAB);
  BAR_L();
  for (int i = tid; i < 384; i += 512) { const int dist = 255 - i; float v;
    if (dist < 0) v = -INFINITY; else if (dist >= 113) v = 0.f; else v = (rel_bias[(int)BKT[dist] * 8 + h] - rel_bias[31 * 8 + h]) * LOG2E;
    tab[i] = v; }
  const bf16* Kh = Zk + rowbase * PITCH + h * 128; const bf16* Vh = Zv + (size_t)((b * 8 + h) * 128) * SEQ;
  unsigned kof0, kof1, vof0, vof1;
  { const int row0 = 8 * wid + (lane >> 4), row1 = row0 + 4, c0 = (lane & 15) ^ (row0 & 7), c1 = (lane & 15) ^ (row1 & 7);
    kof0 = (unsigned)(row0 * PITCH + c0 * 8) * 2u; kof1 = (unsigned)(row1 * PITCH + c1 * 8) * 2u;
    const int dd0 = 16 * wid + (lane >> 3), dd1 = dd0 + 8, cc0 = (lane & 7) ^ ((dd0 >> 1) & 7), cc1 = (lane & 7) ^ ((dd1 >> 1) & 7);
    vof0 = (unsigned)(dd0 * SEQ * 2 + cc0 * 16); vof1 = (unsigned)(dd1 * SEQ * 2 + cc1 * 16); }
  const unsigned lds0 = (unsigned)(uintptr_t)lds;
  const unsigned kdst = (unsigned)__builtin_amdgcn_readfirstlane((int)(lds0 + L3_K + 2 * wid * 1024)), vdst = (unsigned)__builtin_amdgcn_readfirstlane((int)(lds0 + L3_V + 2 * wid * 1024));
#define DMA_K(t, sl) do { const bf16* kb_ = Kh + (long)(t) * KVBLK * PITCH; glds16s(kof0, kb_, kdst + (unsigned)(sl) * SHM_K); glds16s(kof1, kb_, kdst + (unsigned)(sl) * SHM_K + 1024u); } while (0)
#define DMA_V(t, sl) do { const bf16* vb_ = Vh + (long)(t) * KVBLK; glds16s(vof0, vb_, vdst + (unsigned)(sl) * SHM_V); glds16s(vof1, vb_, vdst + (unsigned)(sl) * SHM_V + 1024u); } while (0)
  DMA_K(0, 0); DMA_K(1, 1); DMA_V(0, 0);
  float m_reg = 0.f, l_reg = 0.f; f32x16 o[4] = {}; f32x16 negm = {}; bf16x8 qr[4];
  const bf16* Qw = Zq + (rowbase + q0 + g * QBLK + r32) * PITCH + h * 128 + map * 64 + hi * 8;
#pragma unroll
  for (int d0 = 0; d0 < 4; ++d0) qr[d0] = *reinterpret_cast<const bf16x8*>(Qw + d0 * 16);
  { float qs = 0.f;
#pragma unroll
    for (int d0 = 0; d0 < 4; ++d0)
#pragma unroll
      for (int e = 0; e < 8; ++e) qs += __builtin_fabsf(__uint_as_float((unsigned)(unsigned short)qr[d0][e] << 16));
    { auto rr = __builtin_amdgcn_permlane32_swap(__float_as_uint(qs), __float_as_uint(qs), false, false); qs = __uint_as_float(rr[0]) + __uint_as_float(rr[1]); }
    const float kmx = __uint_as_float(((const __attribute__((address_space(1))) unsigned*)kmaxw)[h * 2 + map]) * 1.01f;
    float bm = __builtin_fabsf((rel_bias[(lane & 31) * 8 + h] - rel_bias[31 * 8 + h]) * LOG2E);
#pragma unroll
    for (int sft = 16; sft >= 1; sft >>= 1) bm = __builtin_fmaxf(bm, __shfl_xor(bm, sft));
    const int okw = __all(qs * kmx + bm <= FAST_B) ? 1 : 0;
    if (lane == 0) ((int*)(lds + L3_FLG))[wid] = okw; }
  int kfa[4];
#pragma unroll
  for (int d0 = 0; d0 < 4; ++d0) kfa[d0] = (int)(uintptr_t)K_lds + KSWZ(r32, (map * 64 + d0 * 16 + hi * 8) * 2);
  int vfb[4];
#pragma unroll
  for (int ks = 0; ks < 4; ++ks) vfb[ks] = (int)(uintptr_t)V_lds + r32 * 128 + (((2 * ks + hi) ^ ((r32 >> 1) & 7)) << 4);
  const int qpos = q0 + g * QBLK + r32;
  const float* tl0 = tab + (255 - qpos + 4 * hi);
  float* al_l = (float*)(lds + L3_WS) + wid * 64 + 32;
  typedef __attribute__((address_space(3))) const bf16x8* lds_frag_p;
#define KFRAG(n, ks_) (*(lds_frag_p)(size_t)(unsigned)(kfa[(n) >> 1] + ((n) & 1) * 8192 + (ks_)))
#define VFRAG(dst, m, vs_) do { dst = *(lds_frag_p)(size_t)(unsigned)(vfb[(m) & 3] + (vs_) + ((m) >> 2) * 4096); } while (0)
  f32x16 pA0, pA1, pB0, pB1; u32x4 pw0 = {}, pw1 = {}, pw2 = {}, pw3 = {}; bf16x8 f[4]; bool resc = false;
#define PWF(k) __builtin_bit_cast(bf16x8, pw##k)
#define BANDADD(C0, C1, T) do { const float* tl_ = tl0 + (T) * KVBLK; _Pragma("unroll") for (int r = 0; r < 16; ++r) { const int c_ = (r & 3) + 8 * (r >> 2); C0[r] += tl_[c_]; C1[r] += tl_[32 + c_]; } } while (0)
#define MOVEREF(C0, C1, DL) do { const float dl_ = (DL); m_reg += dl_; const float al_ = EX2(-dl_); l_reg *= al_; \
    _Pragma("unroll") for (int r = 0; r < 16; ++r) { C0[r] -= dl_; C1[r] -= dl_; negm[r] = -m_reg; } if (hi == 0) al_l[r32] = al_; resc = true; } while (0)
#define RESC() do { if (resc) { asm volatile("s_waitcnt lgkmcnt(0)" ::: "memory"); _Pragma("unroll") for (int d_ = 0; d_ < 4; ++d_) _Pragma("unroll") for (int r = 0; r < 16; ++r) o[d_][r] *= al_l[crow(r, hi)]; resc = false; } } while (0)
  BAR_VL();
  bool fast; { const u32x4 f0_ = ((const u32x4*)(lds + L3_FLG))[0], f1_ = ((const u32x4*)(lds + L3_FLG))[1]; fast = __builtin_amdgcn_readfirstlane((int)(f0_.x & f0_.y & f0_.z & f0_.w & f1_.x & f1_.y & f1_.z & f1_.w)) != 0; }
#define STEP0(FAST) do { _Pragma("unroll") for (int n = 0; n < 8; ++n) { const bf16x8 kf_ = KFRAG(n, 0); \
      if (n & 1) pA1 = MFMA32(kf_, qr[n >> 1], n == 1 ? ((FAST) ? f32x16{} : negm) : pA1); else pA0 = MFMA32(kf_, qr[n >> 1], n == 0 ? ((FAST) ? f32x16{} : negm) : pA0); } \
    if (NT <= 4) BANDADD(pA0, pA1, 0); \
    if (!(FAST)) { float a_ = MX3(pA0[0], pA0[1], pA1[0]), b_ = MX3(pA0[2], pA0[3], pA1[1]); a_ = MX3(a_, pA1[2], pA1[3]); \
      _Pragma("unroll") for (int r = 4; r < 16; r += 4) { a_ = MX3(a_, pA0[r], pA0[r + 1]); b_ = MX3(b_, pA0[r + 2], pA0[r + 3]); a_ = MX3(a_, pA1[r], pA1[r + 1]); b_ = MX3(b_, pA1[r + 2], pA1[r + 3]); } \
      float rm_ = __builtin_fmaxf(a_, b_); { auto rr = __builtin_amdgcn_permlane32_swap(__float_as_uint(rm_), __float_as_uint(rm_), false, false); rm_ = __builtin_fmaxf(__uint_as_float(rr[0]), __uint_as_float(rr[1])); } \
      MOVEREF(pA0, pA1, rm_); resc = false; }                               \
    _Pragma("unroll") for (int r = 0; r < 16; ++r) { pA0[r] = EX2(pA0[r]); pA1[r] = EX2(pA1[r]); } \
    if (2 < NT) DMA_K(2, 2); DMA_V(1, 1); \
    asm volatile("s_waitcnt vmcnt(4) lgkmcnt(0)\n\ts_barrier" ::: "memory"); } while (0)
#define STEP(FAST, STEADY, C0, C1, P0, P1, T, SL) do { const int t_ = (T), sl_ = (SL), prv_ = (sl_ == 0) ? 2 : sl_ - 1, nxt_ = (sl_ == 2) ? 0 : sl_ + 1; \
    const int ks_ = sl_ * SHM_K, vs_ = prv_ * SHM_V; float sacc = 0.f; SBAR(); \
    f[0] = KFRAG(0, ks_); f[1] = KFRAG(1, ks_); SBAR(); \
    _Pragma("unroll") for (int k = 0; k < 8; ++k) { \
      if (k + 2 < 8) f[(k + 2) & 3] = KFRAG(k + 2, ks_); else VFRAG(f[(k + 2) & 3], k + 2 - 8, vs_); \
      SBAR(); \
      if (k & 1) C1 = MFMA32(f[k & 3], qr[k >> 1], k == 1 ? ((FAST) ? f32x16{} : negm) : C1); else C0 = MFMA32(f[k & 3], qr[k >> 1], k == 0 ? ((FAST) ? f32x16{} : negm) : C0); \
      if (k < 4) { sacc += P0[4 * k]; sacc += P0[4 * k + 1]; sacc += P0[4 * k + 2]; sacc += P0[4 * k + 3]; } else { sacc += P1[4 * k - 16]; sacc += P1[4 * k - 15]; sacc += P1[4 * k - 14]; sacc += P1[4 * k - 13]; } \
      PIN(sacc); \
      { const unsigned c0_ = (k < 4) ? cvtpk(P0[4 * k], P0[4 * k + 1]) : cvtpk(P1[4 * k - 16], P1[4 * k - 15]), c1_ = (k < 4) ? cvtpk(P0[4 * k + 2], P0[4 * k + 3]) : cvtpk(P1[4 * k - 14], P1[4 * k - 13]); \
        if (k == 0) { pw0[0] = c0_; pw0[1] = c1_; } else if (k == 1) { pw0[2] = c0_; pw0[3] = c1_; PIN(pw0); } else if (k == 2) { pw1[0] = c0_; pw1[1] = c1_; } else if (k == 3) { pw1[2] = c0_; pw1[3] = c1_; PIN(pw1); } \
        else if (k == 4) { pw2[0] = c0_; pw2[1] = c1_; } else if (k == 5) { pw2[2] = c0_; pw2[3] = c1_; PIN(pw2); } else if (k == 6) { pw3[0] = c0_; pw3[1] = c1_; } else { pw3[2] = c0_; pw3[3] = c1_; PIN(pw3); } } \
      SBAR(); } \
    l_reg += sacc; \
    if ((STEADY) || t_ + 2 < NT) DMA_K(t_ + 2, prv_); if ((STEADY) || t_ + 1 < NT) DMA_V(t_ + 1, nxt_); \
    if (!(STEADY) && t_ >= NT - 4) BANDADD(C0, C1, t_); \
    float a_ = 0.f, b_ = 0.f, rm_ = 0.f; SBAR(); \
    _Pragma("unroll") for (int j = 0; j < 16; ++j) { \
      if (j + 2 < 16) VFRAG(f[(j + 10) & 3], j + 2, vs_); \
      SBAR(); \
      o[j >> 2] = MFMA32((j & 3) == 0 ? PWF(0) : (j & 3) == 1 ? PWF(1) : (j & 3) == 2 ? PWF(2) : PWF(3), f[(j + 8) & 3], o[j >> 2]); \
      if (FAST) { if (j < 8) { C0[2 * j] = EX2(C0[2 * j]); C0[2 * j + 1] = EX2(C0[2 * j + 1]); PIN(C0); } else { C1[2 * j - 16] = EX2(C1[2 * j - 16]); C1[2 * j - 15] = EX2(C1[2 * j - 15]); PIN(C1); } } \
      else if (j == 0) { a_ = MX3(C0[0], C0[1], C1[0]); b_ = MX3(C0[2], C0[3], C1[1]); a_ = MX3(a_, C1[2], C1[3]); a_ = MX3(a_, C0[4], C0[5]); b_ = MX3(b_, C0[6], C0[7]); PIN(a_); PIN(b_); } \
      else if (j == 1) { a_ = MX3(a_, C1[4], C1[5]); b_ = MX3(b_, C1[6], C1[7]); a_ = MX3(a_, C0[8], C0[9]); b_ = MX3(b_, C0[10], C0[11]); a_ = MX3(a_, C1[8], C1[9]); PIN(a_); PIN(b_); } \
      else if (j == 2) { b_ = MX3(b_, C1[10], C1[11]); a_ = MX3(a_, C0[12], C0[13]); b_ = MX3(b_, C0[14], C0[15]); a_ = MX3(a_, C1[12], C1[13]); b_ = MX3(b_, C1[14], C1[15]); PIN(a_); PIN(b_); } \
      else if (j == 3) { rm_ = __builtin_fmaxf(a_, b_); auto rr = __builtin_amdgcn_permlane32_swap(__float_as_uint(rm_), __float_as_uint(rm_), false, false); rm_ = __builtin_fmaxf(__uint_as_float(rr[0]), __uint_as_float(rr[1])); PIN(rm_); \
        SBAR(); if (__builtin_expect(__any(rm_ > THR), 0)) { MOVEREF(C0, C1, __builtin_fmaxf(rm_, 0.f)); } } \
      else if (j < 9) { const int e_ = 3 * (j - 4); C0[e_] = EX2(C0[e_]); C0[e_ + 1] = EX2(C0[e_ + 1]); C0[e_ + 2] = EX2(C0[e_ + 2]); if (j == 8) { C0[15] = EX2(C0[15]); } PIN(C0); } \
      else if (j < 14) { const int e_ = 3 * (j - 9); C1[e_] = EX2(C1[e_]); C1[e_ + 1] = EX2(C1[e_ + 1]); C1[e_ + 2] = EX2(C1[e_ + 2]); if (j == 13) { C1[15] = EX2(C1[15]); } PIN(C1); } \
      SBAR(); } \
    if (!(FAST)) RESC(); } while (0)
#define ENDW(T) do { if ((T) + 2 < NT) asm volatile("s_waitcnt vmcnt(4) lgkmcnt(0)\n\ts_barrier" ::: "memory"); else if ((T) + 1 < NT) asm volatile("s_waitcnt vmcnt(2) lgkmcnt(0)\n\ts_barrier" ::: "memory"); else asm volatile("s_waitcnt vmcnt(0) lgkmcnt(0)\n\ts_barrier" ::: "memory"); } while (0)
  int sl = 1;
#define ENDWS() asm volatile("s_waitcnt vmcnt(4) lgkmcnt(0)\n\ts_barrier" ::: "memory")
#define MAINLOOP(FAST) do { STEP0(FAST); int t = 1; \
    if (FAST) { _Pragma("unroll 1") for (; t + 10 <= NT; t += 6) { \
      STEP(FAST, true, pB0, pB1, pA0, pA1, t, 1); ENDWS(); STEP(FAST, true, pA0, pA1, pB0, pB1, t + 1, 2); ENDWS(); STEP(FAST, true, pB0, pB1, pA0, pA1, t + 2, 0); ENDWS(); \
      STEP(FAST, true, pA0, pA1, pB0, pB1, t + 3, 1); ENDWS(); STEP(FAST, true, pB0, pB1, pA0, pA1, t + 4, 2); ENDWS(); STEP(FAST, true, pA0, pA1, pB0, pB1, t + 5, 0); ENDWS(); } } \
    _Pragma("unroll 1") for (; t + 1 < NT; t += 2) { \
      STEP(FAST, false, pB0, pB1, pA0, pA1, t, sl); ENDW(t); sl = (sl == 2) ? 0 : sl + 1; \
      STEP(FAST, false, pA0, pA1, pB0, pB1, t + 1, sl); ENDW(t + 1); sl = (sl == 2) ? 0 : sl + 1; } \
    STEP(FAST, false, pB0, pB1, pA0, pA1, NT - 1, sl); ENDW(NT - 1); } while (0)
  if (fast) MAINLOOP(true); else MAINLOOP(false);
  { float sacc = 0.f;
    _Pragma("unroll") for (int r = 0; r < 16; ++r) { sacc += pB0[r]; sacc += pB1[r]; }
    l_reg += sacc;
    pw0 = (u32x4){cvtpk(pB0[0], pB0[1]), cvtpk(pB0[2], pB0[3]), cvtpk(pB0[4], pB0[5]), cvtpk(pB0[6], pB0[7])}; pw1 = (u32x4){cvtpk(pB0[8], pB0[9]), cvtpk(pB0[10], pB0[11]), cvtpk(pB0[12], pB0[13]), cvtpk(pB0[14], pB0[15])};
    pw2 = (u32x4){cvtpk(pB1[0], pB1[1]), cvtpk(pB1[2], pB1[3]), cvtpk(pB1[4], pB1[5]), cvtpk(pB1[6], pB1[7])}; pw3 = (u32x4){cvtpk(pB1[8], pB1[9]), cvtpk(pB1[10], pB1[11]), cvtpk(pB1[12], pB1[13]), cvtpk(pB1[14], pB1[15])};
    const int vs_ = sl * SHM_V;
    _Pragma("unroll") for (int j = 0; j < 16; ++j) { bf16x8 vf_; VFRAG(vf_, j, vs_); o[j >> 2] = MFMA32((j & 3) == 0 ? PWF(0) : (j & 3) == 1 ? PWF(1) : (j & 3) == 2 ? PWF(2) : PWF(3), vf_, o[j >> 2]); } }
  { auto rr = __builtin_amdgcn_permlane32_swap(__float_as_uint(l_reg), __float_as_uint(l_reg), false, false); l_reg = __uint_as_float(rr[0]) + __uint_as_float(rr[1]); }
  float* li_l = (float*)(lds + L3_WS) + wid * 64;
  float lam, gmul; { const __attribute__((address_space(1))) float* pp = (const __attribute__((address_space(1))) float*)par; int l2 = layer; asm volatile("" : "+s"(pp), "+s"(l2)); lam = pp[l2]; gmul = 1.f - ((l2 == 0) ? 0.2f : (0.8f - 0.6f * 0.7408182206817179f)); }
  if (hi == 0) li_l[r32] = l_reg; asm volatile("s_waitcnt lgkmcnt(0)" ::: "memory");
  float rli[16];
#pragma unroll
  for (int r = 0; r < 16; ++r) rli[r] = __builtin_amdgcn_rcpf(li_l[crow(r, hi)]);
  float* X = (float*)(lds + L_XCH + g * XCH_WAVE);
  BAR_L();
  if (map == 1) {
#pragma unroll
    for (int d0 = 0; d0 < 4; ++d0)
#pragma unroll
      for (int r = 0; r < 16; ++r) X[crow(r, hi) * XPITCH + d0 * 32 + r32] = o[d0][r] * rli[r];
  }
  BAR_L();
  if (map == 0) {
#pragma unroll
    for (int d0 = 0; d0 < 4; ++d0)
#pragma unroll
      for (int r = 0; r < 16; ++r) { float* xp = &X[crow(r, hi) * XPITCH + d0 * 32 + r32]; *xp = o[d0][r] * rli[r] - lam * (*xp); }
    asm volatile("s_waitcnt lgkmcnt(0)" ::: "memory");
    const f32x4* xr = (const f32x4*)(X + r32 * XPITCH + hi * 64);
    f32x4 v[16]; float ss = 0.f;
#pragma unroll
    for (int i = 0; i < 16; ++i) { v[i] = xr[i]; ss += (v[i][0] * v[i][0] + v[i][1] * v[i][1]) + (v[i][2] * v[i][2] + v[i][3] * v[i][3]); }
    { auto rr = __builtin_amdgcn_permlane32_swap(__float_as_uint(ss), __float_as_uint(ss), false, false); ss = __uint_as_float(rr[0]) + __uint_as_float(rr[1]); }
    const float rs = __builtin_amdgcn_rsqf(ss * (1.0f / 128.0f) + 1e-6f) * gmul;
    bf16* op = Oa + (rowbase + q0 + g * QBLK + r32) * PITCH + h * 128 + hi * 64;
    const f32x4* gp = (const f32x4*)(gsub + hi * 64);
#pragma unroll
    for (int i = 0; i < 16; i += 2) { const f32x4 g0 = gp[i], g1 = gp[i + 1]; u32x4 w;
      w.x = cvtpk(v[i][0] * rs * g0[0], v[i][1] * rs * g0[1]); w.y = cvtpk(v[i][2] * rs * g0[2], v[i][3] * rs * g0[3]);
      w.z = cvtpk(v[i + 1][0] * rs * g1[0], v[i + 1][1] * rs * g1[1]); w.w = cvtpk(v[i + 1][2] * rs * g1[2], v[i + 1][3] * rs * g1[3]);
      *(u32x4*)(op + i * 4) = w; }
  }
#undef DMA_K
#undef DMA_V
#undef KFRAG
#undef VFRAG
#undef PWF
#undef BANDADD
#undef MOVEREF
#undef RESC
#undef STEP
#undef STEP0
#undef ENDWS
#undef MAINLOOP
#undef ENDW
}
#undef PIN
#undef MFMA32
#undef MX3
#undef EX2
#undef BAR_L
#undef BAR_VL
#undef SBAR
}

constexpr int NWAVES = 8;
constexpr int BATCH = 2, SEQ = 16384, D = 1024, M = BATCH * SEQ, NHEAD = 8, INW = 8192, FFD = 2816, NEXP = 8, FFE = 3584;
constexpr float RMS_EPS = 1e-6f;
constexpr float C2 = 0.125f * 1.4426950408889634f;
constexpr int SLOTS = 2 * M + NEXP * 256;
constexpr float H8_SCALE = 8.f, WD8_SCALE = 1024.f;

constexpr size_t MiB = 1u << 20;
constexpr size_t WS_CTL = 0, CTL_ZERO_BYTES = 1 * MiB;
constexpr size_t WS_SSQP = 1 * MiB;
constexpr size_t WS_TOKE = 3 * MiB;
constexpr size_t WS_TOKG = WS_TOKE + (size_t)M * 4;
constexpr size_t WS_TOKR = WS_TOKG + (size_t)M * 8;
constexpr size_t WS_POS  = WS_TOKR + (size_t)M * 4;
constexpr size_t WS_RSG  = WS_POS + (size_t)M * 8;
constexpr size_t WS_PAR  = WS_RSG + (size_t)SLOTS * 4;
constexpr size_t WS_XS   = WS_PAR + 256;
constexpr size_t WS_WCS  = WS_XS + (size_t)M * 4;
constexpr size_t WS_GCS  = WS_WCS + 2 * 8192 * 4;
static_assert(WS_GCS + 5632 * 4 <= 5 * MiB, "small arrays");
constexpr size_t WS_WIN = 5 * MiB;
constexpr size_t WS_WSM = WS_WIN + 2 * (size_t)INW * D * 2;
constexpr size_t WS_WGU = WS_WSM + 6 * (size_t)D * D * 2;
constexpr size_t WS_WDN = WS_WGU + (size_t)2 * FFD * D * 2;
constexpr size_t WS_WEGU = WS_WDN + (size_t)D * FFD * 2;
constexpr size_t WS_WEDN = WS_WEGU + (size_t)NEXP * 2 * FFE * D * 2;
constexpr size_t WS_XQ = WS_WEGU + 56 * MiB;
constexpr size_t WS_XB = WS_WEDN + (size_t)NEXP * D * FFE * 2;
constexpr size_t WS_ARENA = WS_XB + (size_t)M * D * 2;
constexpr size_t ZG = (size_t)M * D * 2;
constexpr size_t WS_HD = WS_ARENA;
constexpr size_t WS_XG = WS_ARENA;
constexpr size_t WS_HE = WS_XG + (size_t)SLOTS * D * 2;
constexpr size_t WS_END = WS_HE + (size_t)SLOTS * FFE * 2;
static_assert(WS_ARENA + 8 * ZG <= WS_END && WS_END <= 896 * MiB, "d_ws map");
constexpr int CW_TMO = 0, CW_BAR = 4096, CW_CNT = 8192, CW_CUR = 8192 + 64, CW_WMAX = 8192 + 128, CW_COLMAX = 16384, CW_GUMAX = 16384 + 2 * 8192, CW_KMAX = CW_GUMAX + 5632, CW_CMXCNT = CW_KMAX + 64;

constexpr int RING_OFF = 0, RING_BYTES = 131072;
constexpr int LDSCTL_OFF = RING_BYTES, MISC_OFF = LDSCTL_OFF + 320;
constexpr int LDS_BYTES = 147456;
static_assert(MISC_OFF + 128 <= LDS_BYTES && dattn::LDS_BYTES <= RING_BYTES && dattn::LDS3_BYTES <= RING_BYTES, "LDS map");

#define GAS __attribute__((address_space(1)))
#define LAS __attribute__((address_space(3)))
typedef unsigned short bf16;
typedef unsigned v4u __attribute__((ext_vector_type(4)));
typedef float f32x4 __attribute__((ext_vector_type(4)));
typedef short bf16x8 __attribute__((ext_vector_type(8)));
typedef GAS unsigned gu32;
typedef GAS unsigned long long gu64;
#define RLX_AGENT __ATOMIC_RELAXED, __HIP_MEMORY_SCOPE_AGENT
#define LDS_WAIT() asm volatile("s_waitcnt lgkmcnt(0)" ::: "memory")
#define VM_WAIT() asm volatile("s_waitcnt vmcnt(0)" ::: "memory")
__device__ __forceinline__ unsigned long long rt() { return __builtin_amdgcn_s_memrealtime(); }
__device__ __forceinline__ unsigned f2bf(float f) { unsigned u = __builtin_bit_cast(unsigned, f); return (u + 0x7fffu + ((u >> 16) & 1u)) >> 16; }
__device__ __forceinline__ unsigned pk2(float lo, float hi) { return f2bf(lo) | (f2bf(hi) << 16); }

#define XB_TMO      128
#define XB_XCNT(j)  (256  + 64 * (j))
#define XB_XSUB(j)  (1280 + 64 * (j))
#define XB_XGEN(j)  (2304 + 64 * (j))
#define XB_TOP      3328
#define XB_TOPGEN   3392
#define XCD_BAR_WORDS 3456
#define XB_SPIN_CAP (1u << 18)

__device__ __forceinline__ unsigned xb_ld(unsigned* p)              { return __hip_atomic_load(p, __ATOMIC_RELAXED, __HIP_MEMORY_SCOPE_AGENT); }
__device__ __forceinline__ unsigned xb_add(unsigned* p, unsigned v) { return __hip_atomic_fetch_add(p, v, __ATOMIC_RELAXED, __HIP_MEMORY_SCOPE_AGENT); }
__device__ __forceinline__ unsigned xb_xcc_id() { return (unsigned)__builtin_amdgcn_s_getreg((3 << 11) | 20) & 0xFu; }
#define XB_SPIN(cond, bar) do { unsigned _sp = 0; while (cond) { __builtin_amdgcn_s_sleep(1); \
    if ((++_sp & 255u) == 0u) { if (xb_ld(&(bar)[XB_TMO])) break; if (_sp > XB_SPIN_CAP) { atomicAdd(&(bar)[XB_TMO], 1u); break; } } } } while (0)

struct XcdBarrier {
    unsigned* bar; unsigned x;
    volatile LAS unsigned* st;
};

__device__ __forceinline__ XcdBarrier xcd_barrier_post(unsigned* bar, volatile LAS unsigned* st) {
    XcdBarrier b; b.bar = bar; b.x = xb_xcc_id(); b.st = st;
    if (threadIdx.x == 0) (void)xb_add(&bar[XB_XCNT(b.x)], 1u);
    return b;
}
__device__ __forceinline__ void xcd_barrier_complete(unsigned* bar, unsigned x, unsigned& nloc, unsigned& nx) {
    const unsigned G = gridDim.x * gridDim.y * gridDim.z;
    unsigned sum, cnt, mine, sp = 0u;
    for (;;) {
        sum = 0u; cnt = 0u; mine = 0u;
#pragma unroll
        for (unsigned j = 0; j < 16; ++j) { const unsigned c = xb_ld(&bar[XB_XCNT(j)]); sum += c; cnt += (c > 0u) ? 1u : 0u; mine = (j == x) ? c : mine; }
        if (sum == G) break;
        __builtin_amdgcn_s_sleep(1);
        if ((++sp & 255u) == 0u) { if (xb_ld(&bar[XB_TMO])) break; if (sp > XB_SPIN_CAP) { atomicAdd(&bar[XB_TMO], 1u); break; } }
    }
    nloc = mine > 0u ? mine : 1u; nx = cnt > 0u ? cnt : 1u;
}

__device__ __forceinline__ void xcd_barrier(const XcdBarrier& b) {
    asm volatile("s_waitcnt vmcnt(0)" ::: "memory");
    __syncthreads();
    if (threadIdx.x == 0) {
        unsigned* bar = b.bar;
        __builtin_amdgcn_s_waitcnt(0);
        unsigned nloc = b.st[0], nx = b.st[1];
        if (nloc == 0u) { xcd_barrier_complete(bar, b.x, nloc, nx); b.st[0] = nloc; b.st[1] = nx; }
        const unsigned old = xb_add(&bar[XB_XSUB(b.x)], 1u);
        const unsigned gen = old / nloc;
        if (old + 1u == (gen + 1u) * nloc) {
            __builtin_amdgcn_fence(__ATOMIC_RELEASE, "agent");
            asm volatile("s_waitcnt vmcnt(0)" ::: "memory");
            const unsigned og = xb_add(&bar[XB_TOP], 1u);
            const unsigned tg = og / nx;
            if (og + 1u == (tg + 1u) * nx) xb_add(&bar[XB_TOPGEN], 1u);
            else XB_SPIN(xb_ld(&bar[XB_TOPGEN]) == tg, bar);
            __builtin_amdgcn_fence(__ATOMIC_ACQUIRE, "agent");
            xb_add(&bar[XB_XGEN(b.x)], 1u);
            asm volatile("s_waitcnt vmcnt(0)" ::: "memory");
        } else {
            XB_SPIN(xb_ld(&bar[XB_XGEN(b.x)]) == gen, bar);
            __builtin_amdgcn_fence(__ATOMIC_ACQUIRE, "agent");
            asm volatile("s_waitcnt vmcnt(0)" ::: "memory");
        }
    }
    __syncthreads();
}

struct Frame {
    LAS unsigned char* lds;
    volatile LAS unsigned* MISC;
    int tid, lane, wave;
    int vcu, G;
};
__device__ __forceinline__ Frame refresh(const Frame& F0) { Frame F = F0; int l_; asm volatile("v_mbcnt_lo_u32_b32 %0, -1, 0\n\tv_mbcnt_hi_u32_b32 %0, -1, %0" : "=v"(l_)); F.lane = l_; F.tid = F0.wave * 64 + l_; return F; }
typedef unsigned u32x2_t __attribute__((ext_vector_type(2)));
typedef float f32x2_t __attribute__((ext_vector_type(2)));
typedef int i32x2_t __attribute__((ext_vector_type(2)));
__device__ __forceinline__ float wave_sum(float v) {
#pragma unroll
    for (int o = 1; o < 64; o <<= 1) v += __shfl_xor(v, o);
    return v;
}
__device__ __forceinline__ void unpack8(const v4u w, float (&f)[8]) {
    f[0] = __uint_as_float(w.x << 16); f[1] = __uint_as_float(w.x & 0xffff0000u); f[2] = __uint_as_float(w.y << 16); f[3] = __uint_as_float(w.y & 0xffff0000u);
    f[4] = __uint_as_float(w.z << 16); f[5] = __uint_as_float(w.z & 0xffff0000u); f[6] = __uint_as_float(w.w << 16); f[7] = __uint_as_float(w.w & 0xffff0000u);
}
__device__ __forceinline__ void p0_transpose_item(const float* W, int K, int N, bf16* WT, int orow0, int k0, int n0, const float* gk, float cs, LAS float* scr, int lane) {
#pragma unroll 32
    for (int i = 0; i < 32; ++i) { const int kk = 2 * i + (lane >> 5); const float s = gk ? gk[k0 + kk] * cs : cs; scr[kk * 33 + (lane & 31)] = W[(size_t)(k0 + kk) * N + n0 + (lane & 31)] * s; }
    LDS_WAIT(); asm volatile("" ::: "memory");
    const int c = lane & 7;
#pragma unroll
    for (int j = 0; j < 4; ++j) { const int n = (lane >> 3) + 8 * j; const LAS float* s = scr + (8 * c) * 33 + n;
        v4u o; o.x = pk2(s[0 * 33], s[1 * 33]); o.y = pk2(s[2 * 33], s[3 * 33]); o.z = pk2(s[4 * 33], s[5 * 33]); o.w = pk2(s[6 * 33], s[7 * 33]);
        *(GAS v4u*)(WT + (size_t)(orow0 + n) * K + k0 + 8 * c) = o; }
    LDS_WAIT(); asm volatile("" ::: "memory");
}
__device__ __forceinline__ int win_row(int n0) { if (n0 < 3072 || n0 >= 6144) return n0; if (n0 < 4096) { const int j = (n0 - 3072) >> 7, i = (n0 - 3072) & 127; return 3072 + 256 * j + i; }
    if (n0 < 5120) { const int blk = (n0 - 4096) >> 7, i = (n0 - 4096) & 127; return 5120 + 256 * (blk & 3) + 128 * (blk >> 2) + i; }
    const int j = (n0 - 5120) >> 7, i = (n0 - 5120) & 127; return 3072 + 256 * j + 128 + i; }
__device__ __forceinline__ int gu_row(int n0, int F) { const int bj = n0 / F, j = n0 - bj * F; return 256 * (j >> 7) + 128 * bj + (j & 127); }

struct Args { const float* in[17]; float* out; unsigned char* ws; };
#define AS4 __attribute__((address_space(4)))
__device__ __forceinline__ const AS4 Args* kargs() { const AS4 Args* p = (const AS4 Args*)__builtin_amdgcn_kernarg_segment_ptr(); asm volatile("" : "+s"(p)); return p; }
enum { I_X = 0, I_RELB, I_MIXG, I_WIN, I_LAMQK, I_SUBLN, I_CONVW, I_WOA, I_WOC, I_WO, I_FFNG, I_DGU, I_DDN, I_ROUTER, I_EGU, I_EDN, I_FING };

__device__ __forceinline__ void winq_items(const Frame& F, const AS4 Args* A_, int l);
__device__ __forceinline__ void p0_prologue(const Frame& F0) {
    const Frame F = refresh(F0);
    const AS4 Args* A_ = kargs(); const AS4 Args& A = *A_; unsigned char* const Fws = A.ws;
    LAS float* scr = (LAS float*)(F.lds + RING_OFF + F.wave * 16384);
    const int gw = F.vcu * NWAVES + F.wave, NGW = F.G * NWAVES;
    constexpr int I_A = 2 * 16 * 256, I_B = 6 * 512, I_C = 16 * 176, I_D = 44 * 32, I_E = 8 * 16 * 224, I_F = 8 * 56 * 32;
    constexpr int NITEMS = I_A + I_B + I_C + I_D + I_E + I_F;
    for (int it = gw; it < NITEMS; it += NGW) {
        int r = it;
        if (r < I_A) { const int l = r / 4096, rr = r % 4096, kb = rr / 256, nb = rr % 256;
            const float* W = A.in[I_WIN] + (size_t)l * D * INW; const float* gk = A.in[I_MIXG] + l * D; float mx = 0.f;
#pragma unroll 32
            for (int i = 0; i < 32; ++i) { const int kk = 64 * kb + 2 * i + (F.lane >> 5); mx = fmaxf(mx, fabsf(W[(size_t)kk * INW + 32 * nb + (F.lane & 31)] * gk[kk])); }
            mx = fmaxf(mx, __shfl_xor(mx, 32));
            if (F.lane < 32) __hip_atomic_fetch_max((unsigned*)((gu32*)(Fws + WS_CTL) + CW_COLMAX) + l * INW + win_row(32 * nb) + F.lane, __float_as_uint(mx), __ATOMIC_RELAXED, __HIP_MEMORY_SCOPE_AGENT);
            if (l == 0) { asm volatile("s_waitcnt vmcnt(0)" ::: "memory");
                if (F.lane == 0) __hip_atomic_fetch_add((unsigned*)((gu32*)(Fws + WS_CTL) + CW_CMXCNT) + 64 * (gw & 7), 1u, __ATOMIC_RELAXED, __HIP_MEMORY_SCOPE_AGENT); }
            continue; }
        r -= I_A;
        if (r < I_B) { const int idx = r / 512, rr = r % 512, l = idx / 3, which = idx % 3, kb = rr / 32, nb = rr % 32;
            const float* W = (which == 0 ? A.in[I_WOA] : which == 1 ? A.in[I_WOC] : A.in[I_WO]) + (size_t)l * D * D;
            p0_transpose_item(W, D, D, (bf16*)(Fws + WS_WSM) + (size_t)idx * D * D, 32 * nb, 64 * kb, 32 * nb, nullptr, 1.f, scr, F.lane); continue; }
        r -= I_B;
        if (r < I_C) { const int kb = r / 176, nb = r % 176;
            const float* W = A.in[I_DGU]; const float* gk = A.in[I_FFNG]; float mx = 0.f;
#pragma unroll 32
            for (int i = 0; i < 32; ++i) { const int kk = 64 * kb + 2 * i + (F.lane >> 5); mx = fmaxf(mx, fabsf(W[(size_t)kk * (2 * FFD) + 32 * nb + (F.lane & 31)] * gk[kk])); }
            mx = fmaxf(mx, __shfl_xor(mx, 32));
            if (F.lane < 32) __hip_atomic_fetch_max((unsigned*)((gu32*)(Fws + WS_CTL) + CW_GUMAX) + gu_row(32 * nb, FFD) + F.lane, __float_as_uint(mx), __ATOMIC_RELAXED, __HIP_MEMORY_SCOPE_AGENT);
            continue; }
        r -= I_C;
        if (r < I_D) { const int kb = r / 32, nb = r % 32, k0 = 64 * kb, n0 = 32 * nb;
            const float* W = A.in[I_DDN];
#pragma unroll 32
            for (int i = 0; i < 32; ++i) { const int kk = 2 * i + (F.lane >> 5); scr[kk * 33 + (F.lane & 31)] = fminf(fmaxf(W[(size_t)(k0 + kk) * D + n0 + (F.lane & 31)] * WD8_SCALE, -448.f), 448.f); }
            LDS_WAIT(); asm volatile("" ::: "memory");
            const int n = F.lane >> 1, hf = F.lane & 1; const LAS float* s = scr + (32 * hf) * 33 + n; unsigned w[8];
#pragma unroll
            for (int j = 0; j < 8; ++j) w[j] = pg8::pack4_fp8(s[(4 * j + 0) * 33], s[(4 * j + 1) * 33], s[(4 * j + 2) * 33], s[(4 * j + 3) * 33]);
            unsigned char* dst = Fws + WS_WDN + ((size_t)(n0 + n)) * FFD + k0 + 32 * hf;
            *(GAS v4u*)dst = (v4u){w[0], w[1], w[2], w[3]}; *(GAS v4u*)(dst + 16) = (v4u){w[4], w[5], w[6], w[7]};
            LDS_WAIT(); asm volatile("" ::: "memory"); continue; }
        r -= I_D;
        if (r < I_E) continue;
        r -= I_E;
        { const int e = r / 1792, rr = r % 1792, kb = rr / 32, nb = rr % 32, k0 = 64 * kb, n0 = 32 * nb;
            const float* W = A.in[I_EDN] + (size_t)e * FFE * D;
#pragma unroll 32
            for (int i = 0; i < 32; ++i) { const int kk = 2 * i + (F.lane >> 5); scr[kk * 33 + (F.lane & 31)] = fminf(fmaxf(W[(size_t)(k0 + kk) * D + n0 + (F.lane & 31)] * WD8_SCALE, -448.f), 448.f); }
            LDS_WAIT(); asm volatile("" ::: "memory");
            const int n = F.lane >> 1, hf = F.lane & 1; const LAS float* s = scr + (32 * hf) * 33 + n; unsigned w[8];
#pragma unroll
            for (int j = 0; j < 8; ++j) w[j] = pg8::pack4_fp8(s[(4 * j + 0) * 33], s[(4 * j + 1) * 33], s[(4 * j + 2) * 33], s[(4 * j + 3) * 33]);
            unsigned char* dst = Fws + WS_WEDN + ((size_t)e * D + n0 + n) * FFE + k0 + 32 * hf;
            *(GAS v4u*)dst = (v4u){w[0], w[1], w[2], w[3]}; *(GAS v4u*)(dst + 16) = (v4u){w[4], w[5], w[6], w[7]};
            LDS_WAIT(); asm volatile("" ::: "memory"); }
    }
    for (int s4 = gw; s4 < 4 * 8 * 64; s4 += NGW) if ((s4 & 3) == 0) { const int sj = s4 >> 2, e = sj >> 6, k = 16 * (sj & 63); const float* W = A.in[I_EGU] + (size_t)e * D * 2 * FFE + (size_t)k * (2 * FFE); const float gkk = A.in[I_FFNG][D + k];
        float mx = 0.f; f32x4 v[28];
#pragma unroll
        for (int i = 0; i < 28; ++i) v[i] = *(const f32x4*)(W + F.lane * 4 + 256 * i);
#pragma unroll
        for (int i = 0; i < 28; ++i) mx = fmaxf(fmaxf(mx, fmaxf(fabsf(v[i][0]), fabsf(v[i][1]))), fmaxf(fabsf(v[i][2]), fabsf(v[i][3])));
        mx *= fabsf(gkk);
#pragma unroll
        for (int o = 1; o < 64; o <<= 1) mx = fmaxf(mx, __shfl_xor(mx, o));
        if (F.lane == 0) __hip_atomic_fetch_max((unsigned*)((gu32*)(Fws + WS_CTL) + CW_WMAX) + 64 * e, __float_as_uint(mx * 1.25f), __ATOMIC_RELAXED, __HIP_MEMORY_SCOPE_AGENT); }
    const float* x = A.in[I_X]; unsigned char* XQ = Fws + WS_XQ; float* xsc = (float*)(Fws + WS_XS); float* ssqp = (float*)(Fws + WS_SSQP);
#pragma unroll 1
    for (int mb = gw; mb < M; mb += 4 * NGW) {
        f32x4 v[4][4]; float s[4], mx[4];
#pragma unroll
        for (int k = 0; k < 4; ++k) { const int m = (mb + k * NGW < M) ? mb + k * NGW : mb; const GAS f32x4* xr = (const GAS f32x4*)(x + (size_t)m * D) + F.lane;
#pragma unroll
            for (int j = 0; j < 4; ++j) v[k][j] = xr[64 * j]; }
#pragma unroll
        for (int k = 0; k < 4; ++k) { s[k] = 0.f; mx[k] = 0.f;
#pragma unroll
            for (int j = 0; j < 4; ++j) { s[k] += (v[k][j].x * v[k][j].x + v[k][j].y * v[k][j].y) + (v[k][j].z * v[k][j].z + v[k][j].w * v[k][j].w);
                mx[k] = fmaxf(fmaxf(mx[k], fmaxf(fabsf(v[k][j].x), fabsf(v[k][j].y))), fmaxf(fabsf(v[k][j].z), fabsf(v[k][j].w))); } }
#pragma unroll
        for (int o = 1; o < 64; o <<= 1)
#pragma unroll
            for (int k = 0; k < 4; ++k) { s[k] += __shfl_xor(s[k], o); mx[k] = fmaxf(mx[k], __shfl_xor(mx[k], o)); }
#pragma unroll
        for (int k = 0; k < 4; ++k) { if (mb + k * NGW < M) { const int m = mb + k * NGW;
            const float sa = mx[k] > 0.f ? mx[k] * (1.0f / 127.0f) : 1.f, inv = 1.0f / sa;
            GAS unsigned* o4 = (GAS unsigned*)(XQ + (size_t)m * D) + F.lane;
#pragma unroll
            for (int j = 0; j < 4; ++j) { const int q0 = (int)rintf(v[k][j].x * inv), q1 = (int)rintf(v[k][j].y * inv), q2 = (int)rintf(v[k][j].z * inv), q3 = (int)rintf(v[k][j].w * inv);
                o4[64 * j] = (unsigned)(q0 & 255) | ((unsigned)(q1 & 255) << 8) | ((unsigned)(q2 & 255) << 16) | ((unsigned)(q3 & 255) << 24); }
            if (F.lane == 0) xsc[m] = sa / sqrtf(s[k] * (1.0f / D) + RMS_EPS); } }
    }
    { unsigned got = 0;
      for (unsigned sp = 0; sp < (1u << 22); ++sp) { const unsigned c = __hip_atomic_load((unsigned*)((gu32*)(Fws + WS_CTL) + CW_CMXCNT) + 64 * (F.lane & 7), __ATOMIC_RELAXED, __HIP_MEMORY_SCOPE_AGENT);
          got = c; got += __shfl_xor(got, 1); got += __shfl_xor(got, 2); got += __shfl_xor(got, 4);
          if (got >= 4096u) break; __builtin_amdgcn_s_sleep(8); }
      asm volatile("" ::: "memory"); }
    winq_items(F, A_, 0);
    if (gw == 0) {
        float* par = (float*)(Fws + WS_PAR);
#pragma unroll
        for (int l = 0; l < 2; ++l) { const float* lq = A.in[I_LAMQK] + l * 256;
            const float sa = wave_sum(lq[F.lane] * lq[64 + F.lane]), sb = wave_sum(lq[128 + F.lane] * lq[192 + F.lane]);
            const float lam_init = (l == 0) ? 0.2f : (0.8f - 0.6f * 0.7408182206817179f);
            if (F.lane == 0) par[l] = expf(sa) - expf(sb) + lam_init; }
    }
}

__device__ __forceinline__ void conv_phase(const Frame& F0, int l) {
    const Frame F = refresh(F0);
    const AS4 Args* A_ = kargs(); unsigned char* const Fws = A_->ws; const float* cw = A_->in[I_CONVW] + (size_t)l * 3 * D;
    const bf16* Uu = (const bf16*)(Fws + WS_ARENA + 3 * ZG); bf16* Bb = (bf16*)(Fws + WS_ARENA + 4 * ZG);
    const int nthr = F.G * NWAVES * 64, gt = F.vcu * NWAVES * 64 + F.tid;
    if (F.G == 256) {
        const bf16* Bh = (const bf16*)(Fws + WS_SSQP);
        for (int idx = gt; idx < (M / 256) * 2 * 128; idx += nthr) {
            const int pr = idx >> 7, col = (idx & 127) * 8, m = (pr >> 1) * 256 + (pr & 1), t = m & (SEQ - 1); const size_t o = (size_t)m * D + col;
            float u0[8], u1[8], u2[8], bb[8];
            unpack8(*(const v4u*)(Uu + o), u0); unpack8(*(const v4u*)(Bh + (size_t)pr * D + col), bb);
            if (t >= 1) unpack8(*(const v4u*)(Uu + o - D), u1); else {
#pragma unroll
                for (int i = 0; i < 8; ++i) u1[i] = 0.f; }
            if (t >= 2) unpack8(*(const v4u*)(Uu + o - 2 * D), u2); else {
#pragma unroll
                for (int i = 0; i < 8; ++i) u2[i] = 0.f; }
            float r[8];
#pragma unroll
            for (int i = 0; i < 8; ++i) r[i] = bb[i] * (cw[col + i] * u2[i] + cw[D + col + i] * u1[i] + cw[2 * D + col + i] * u0[i]);
            v4u w; w.x = pk2(r[0], r[1]); w.y = pk2(r[2], r[3]); w.z = pk2(r[4], r[5]); w.w = pk2(r[6], r[7]);
            *(v4u*)(Bb + o) = w;
        }
        return;
    }
    for (int idx = gt; idx < M * 128; idx += nthr) {
        const int m = idx >> 7, col = (idx & 127) * 8, t = m & (SEQ - 1); const size_t o = (size_t)m * D + col;
        float u0[8], u1[8], u2[8], bb[8];
        unpack8(*(const v4u*)(Uu + o), u0); unpack8(*(const v4u*)(Bb + o), bb);
        if (t >= 1) unpack8(*(const v4u*)(Uu + o - D), u1); else {
#pragma unroll
            for (int i = 0; i < 8; ++i) u1[i] = 0.f; }
        if (t >= 2) unpack8(*(const v4u*)(Uu + o - 2 * D), u2); else {
#pragma unroll
            for (int i = 0; i < 8; ++i) u2[i] = 0.f; }
        float r[8];
#pragma unroll
        for (int i = 0; i < 8; ++i) r[i] = bb[i] * (cw[col + i] * u2[i] + cw[D + col + i] * u1[i] + cw[2 * D + col + i] * u0[i]);
        v4u w; w.x = pk2(r[0], r[1]); w.y = pk2(r[2], r[3]); w.z = pk2(r[4], r[5]); w.w = pk2(r[6], r[7]);
        *(v4u*)(Bb + o) = w;
    }
}

__device__ __forceinline__ void winq_items(const Frame& F, const AS4 Args* A_, int l) {
    unsigned char* const Fws = A_->ws; const float* W = A_->in[I_WIN] + (size_t)l * D * INW; const float* gk = A_->in[I_MIXG] + l * D;
    LAS float* scr = (LAS float*)(F.lds + RING_OFF + F.wave * 16384);
    const unsigned* cmx = (const unsigned*)((gu32*)(Fws + WS_CTL) + CW_COLMAX) + l * INW;
    const int gw = F.vcu * NWAVES + F.wave, NGW = F.G * NWAVES;
    for (int it = gw; it < 16 * 256; it += NGW) { const int kb = it / 256, nb = it % 256, k0 = 64 * kb, n0 = 32 * nb, r0 = win_row(n0);
        const float cm = __uint_as_float(__hip_atomic_load(cmx + r0 + (F.lane & 31), __ATOMIC_RELAXED, __HIP_MEMORY_SCOPE_AGENT)), inv = cm > 0.f ? 127.f / cm : 0.f;
        if (kb == 0 && F.lane < 32) ((float*)(Fws + WS_WCS))[l * INW + r0 + F.lane] = cm * (1.0f / 127.0f);
#pragma unroll 32
        for (int i = 0; i < 32; ++i) { const int kk = 2 * i + (F.lane >> 5); scr[kk * 33 + (F.lane & 31)] = W[(size_t)(k0 + kk) * INW + n0 + (F.lane & 31)] * gk[k0 + kk] * inv; }
        LDS_WAIT(); asm volatile("" ::: "memory");
        const int n = F.lane >> 1, hf = F.lane & 1; const LAS float* s = scr + (32 * hf) * 33 + n; unsigned w[8];
#pragma unroll
        for (int j = 0; j < 8; ++j) { const int q0 = (int)rintf(s[(4 * j + 0) * 33]), q1 = (int)rintf(s[(4 * j + 1) * 33]), q2 = (int)rintf(s[(4 * j + 2) * 33]), q3 = (int)rintf(s[(4 * j + 3) * 33]);
            w[j] = (unsigned)(q0 & 255) | ((unsigned)(q1 & 255) << 8) | ((unsigned)(q2 & 255) << 16) | ((unsigned)(q3 & 255) << 24); }
        unsigned char* dst = Fws + WS_WIN + ((size_t)l * INW + r0 + n) * D + k0 + 32 * hf;
        *(GAS v4u*)dst = (v4u){w[0], w[1], w[2], w[3]}; *(GAS v4u*)(dst + 16) = (v4u){w[4], w[5], w[6], w[7]};
        LDS_WAIT(); asm volatile("" ::: "memory");
    }
}
__device__ __forceinline__ void dgq_items(const Frame& F, const AS4 Args* A_) {
    unsigned char* const Fws = A_->ws; const float* W = A_->in[I_DGU]; const float* gk = A_->in[I_FFNG];
    LAS float* scr = (LAS float*)(F.lds + RING_OFF + F.wave * 16384);
    const unsigned* cmx = (const unsigned*)((gu32*)(Fws + WS_CTL) + CW_GUMAX);
    const int gw = F.vcu * NWAVES + F.wave, NGW = F.G * NWAVES;
    for (int it = gw; it < 16 * 176; it += NGW) { const int kb = it / 176, nb = it % 176, k0 = 64 * kb, n0 = 32 * nb, r0 = gu_row(n0, FFD);
        const float cm = __uint_as_float(__hip_atomic_load(cmx + r0 + (F.lane & 31), __ATOMIC_RELAXED, __HIP_MEMORY_SCOPE_AGENT)), inv = cm > 0.f ? 127.f / cm : 0.f;
        if (kb == 0 && F.lane < 32) ((float*)(Fws + WS_GCS))[r0 + F.lane] = cm * (1.0f / 127.0f);
#pragma unroll 32
        for (int i = 0; i < 32; ++i) { const int kk = 2 * i + (F.lane >> 5); scr[kk * 33 + (F.lane & 31)] = W[(size_t)(k0 + kk) * (2 * FFD) + n0 + (F.lane & 31)] * gk[k0 + kk] * inv; }
        LDS_WAIT(); asm volatile("" ::: "memory");
        const int n = F.lane >> 1, hf = F.lane & 1; const LAS float* s = scr + (32 * hf) * 33 + n; unsigned w[8];
#pragma unroll
        for (int j = 0; j < 8; ++j) { const int q0 = (int)rintf(s[(4 * j + 0) * 33]), q1 = (int)rintf(s[(4 * j + 1) * 33]), q2 = (int)rintf(s[(4 * j + 2) * 33]), q3 = (int)rintf(s[(4 * j + 3) * 33]);
            w[j] = (unsigned)(q0 & 255) | ((unsigned)(q1 & 255) << 8) | ((unsigned)(q2 & 255) << 16) | ((unsigned)(q3 & 255) << 24); }
        unsigned char* dst = Fws + WS_WGU + ((size_t)r0 + n) * D + k0 + 32 * hf;
        *(GAS v4u*)dst = (v4u){w[0], w[1], w[2], w[3]}; *(GAS v4u*)(dst + 16) = (v4u){w[4], w[5], w[6], w[7]};
        LDS_WAIT(); asm volatile("" ::: "memory");
    }
}
__device__ __forceinline__ void winq_phase(const Frame& F0, int l) { const Frame F = refresh(F0); winq_items(F, kargs(), l); }
__device__ __forceinline__ void wq_phase(const Frame& F0) {
    const Frame F = refresh(F0);
    const AS4 Args* A_ = kargs(); unsigned char* const Fws = A_->ws; const float* Wall = A_->in[I_EGU]; const float* gk = A_->in[I_FFNG] + D;
    dgq_items(F, A_);
    winq_items(F, A_, 1);
    LAS float* scr = (LAS float*)(F.lds + RING_OFF + F.wave * 16384);
    const int gw = F.vcu * NWAVES + F.wave, NGW = F.G * NWAVES;
    for (int it = gw; it < 8 * 16 * 224; it += NGW) {
        const int e = it / 3584, rr = it % 3584, kb = rr / 224, nb = rr % 224, k0 = 64 * kb, n0 = 32 * nb;
        const float wmax = __uint_as_float(__hip_atomic_load((unsigned*)((gu32*)(Fws + WS_CTL) + CW_WMAX) + 64 * e, __ATOMIC_RELAXED, __HIP_MEMORY_SCOPE_AGENT));
        const float inv = wmax > 0.f ? 127.f / wmax : 0.f;
        const float* W = Wall + (size_t)e * D * 2 * FFE;
#pragma unroll 32
        for (int i = 0; i < 32; ++i) { const int kk = 2 * i + (F.lane >> 5); scr[kk * 33 + (F.lane & 31)] = W[(size_t)(k0 + kk) * (2 * FFE) + n0 + (F.lane & 31)] * gk[k0 + kk] * inv; }
        LDS_WAIT(); asm volatile("" ::: "memory");
        const int n = F.lane >> 1, hf = F.lane & 1; const LAS float* s = scr + (32 * hf) * 33 + n;
        unsigned w[8];
#pragma unroll
        for (int j = 0; j < 8; ++j) { const int q0 = (int)rintf(fminf(fmaxf(s[(4 * j + 0) * 33], -127.f), 127.f)), q1 = (int)rintf(fminf(fmaxf(s[(4 * j + 1) * 33], -127.f), 127.f)), q2 = (int)rintf(fminf(fmaxf(s[(4 * j + 2) * 33], -127.f), 127.f)), q3 = (int)rintf(fminf(fmaxf(s[(4 * j + 3) * 33], -127.f), 127.f));
            w[j] = (unsigned)(q0 & 255) | ((unsigned)(q1 & 255) << 8) | ((unsigned)(q2 & 255) << 16) | ((unsigned)(q3 & 255) << 24); }
        unsigned char* dst = Fws + WS_WEGU + ((size_t)e * 2 * FFE + gu_row(n0, FFE) + n) * D + k0 + 32 * hf;
        *(GAS v4u*)dst = (v4u){w[0], w[1], w[2], w[3]}; *(GAS v4u*)(dst + 16) = (v4u){w[4], w[5], w[6], w[7]};
        LDS_WAIT(); asm volatile("" ::: "memory");
    }
}

__device__ __forceinline__ void rowquant_phase(const Frame& F0) {
    const Frame F = refresh(F0);
    const AS4 Args* A_ = kargs(); unsigned char* const Fws = A_->ws; const bf16* XB = (const bf16*)(Fws + WS_XB); unsigned char* XQ = Fws + WS_XQ; float* xsc = (float*)(Fws + WS_XS);
    const int gw = F.vcu * NWAVES + F.wave, NGW = F.G * NWAVES;
    for (int m = gw; m < M; m += NGW) {
        const v4u* src = (const v4u*)(XB + (size_t)m * D) + 2 * F.lane; const v4u a = src[0], b = src[1];
        float f[16]; { float t0[8], t1[8]; unpack8(a, t0); unpack8(b, t1);
#pragma unroll
            for (int i = 0; i < 8; ++i) { f[i] = t0[i]; f[8 + i] = t1[i]; } }
        float mx = 0.f, ss = 0.f;
#pragma unroll
        for (int i = 0; i < 16; ++i) { mx = fmaxf(mx, fabsf(f[i])); ss += f[i] * f[i]; }
#pragma unroll
        for (int o = 1; o < 64; o <<= 1) mx = fmaxf(mx, __shfl_xor(mx, o));
        ss = wave_sum(ss);
        const float sa = mx > 0.f ? mx * (1.0f / 127.0f) : 1.f, inv = 1.0f / sa; unsigned w[4];
#pragma unroll
        for (int j = 0; j < 4; ++j) { const int q0 = (int)rintf(f[4 * j] * inv), q1 = (int)rintf(f[4 * j + 1] * inv), q2 = (int)rintf(f[4 * j + 2] * inv), q3 = (int)rintf(f[4 * j + 3] * inv);
            w[j] = (unsigned)(q0 & 255) | ((unsigned)(q1 & 255) << 8) | ((unsigned)(q2 & 255) << 16) | ((unsigned)(q3 & 255) << 24); }
        *((v4u*)(XQ + (size_t)m * D) + F.lane) = (v4u){w[0], w[1], w[2], w[3]};
        if (F.lane == 0) xsc[m] = sa / sqrtf(ss * (1.0f / D) + RMS_EPS);
    }
}

__device__ __forceinline__ int router_phase(const Frame& F0) {
    const Frame F = refresh(F0);
    const AS4 Args* A_ = kargs(); unsigned char* const Fws = A_->ws; gu32* const Fctl = (gu32*)(Fws + WS_CTL); const bf16* xr_ = (const bf16*)(Fws + WS_XB); const float* Wr = A_->in[I_ROUTER]; const float* gff = A_->in[I_FFNG] + D;
    const int gw = F.vcu * NWAVES + F.wave, NGW = F.G * NWAVES, rpw = (M + NGW - 1) / NGW;
    unsigned* toke = (unsigned*)(Fws + WS_TOKE); float* tokg = (float*)(Fws + WS_TOKG); float* tokr = (float*)(Fws + WS_TOKR);
    int mycnt = 0;
    const int r0 = gw * rpw, r1 = (r0 + rpw < M) ? r0 + rpw : M;
    float wg[16][8];
#pragma unroll
    for (int j = 0; j < 4; ++j) { const int k0 = 4 * F.lane + 256 * j; const f32x4 gk = *(const f32x4*)(gff + k0);
#pragma unroll
        for (int c = 0; c < 4; ++c) { const f32x4 a = *(const f32x4*)(Wr + (size_t)(k0 + c) * 8), b = *(const f32x4*)(Wr + (size_t)(k0 + c) * 8 + 4);
            wg[4 * j + c][0] = a[0] * gk[c]; wg[4 * j + c][1] = a[1] * gk[c]; wg[4 * j + c][2] = a[2] * gk[c]; wg[4 * j + c][3] = a[3] * gk[c];
            wg[4 * j + c][4] = b[0] * gk[c]; wg[4 * j + c][5] = b[1] * gk[c]; wg[4 * j + c][6] = b[2] * gk[c]; wg[4 * j + c][7] = b[3] * gk[c]; } }
    const bool b5 = (F.lane & 32) != 0, b4 = (F.lane & 16) != 0, b3 = (F.lane & 8) != 0;
    u32x2_t nx[4] = {};
    if (r0 < r1) { const u32x2_t* xr = (const u32x2_t*)(xr_ + (size_t)r0 * D) + F.lane;
#pragma unroll
        for (int j = 0; j < 4; ++j) nx[j] = xr[64 * j]; }
#pragma unroll 1
    for (int m = r0; m < r1; ++m) {
        u32x2_t cx[4];
#pragma unroll
        for (int j = 0; j < 4; ++j) cx[j] = nx[j];
        if (m + 1 < r1) { const u32x2_t* xr = (const u32x2_t*)(xr_ + (size_t)(m + 1) * D) + F.lane;
#pragma unroll
            for (int j = 0; j < 4; ++j) nx[j] = xr[64 * j]; }
        float lg[8] = {0.f, 0.f, 0.f, 0.f, 0.f, 0.f, 0.f, 0.f}; float ss = 0.f;
#pragma unroll
        for (int j = 0; j < 4; ++j) { const f32x4 v = {__uint_as_float(cx[j].x << 16), __uint_as_float(cx[j].x & 0xffff0000u), __uint_as_float(cx[j].y << 16), __uint_as_float(cx[j].y & 0xffff0000u)};
            ss += (v[0] * v[0] + v[1] * v[1]) + (v[2] * v[2] + v[3] * v[3]);
#pragma unroll
            for (int c = 0; c < 4; ++c)
#pragma unroll
                for (int e = 0; e < 8; ++e) lg[e] += v[c] * wg[4 * j + c][e]; }
        float r4[4], r2[2], r1_;
#pragma unroll
        for (int i = 0; i < 4; ++i) { const float keep = b5 ? lg[i + 4] : lg[i], send = b5 ? lg[i] : lg[i + 4]; r4[i] = keep + __shfl_xor(send, 32); }
#pragma unroll
        for (int i = 0; i < 2; ++i) { const float keep = b4 ? r4[i + 2] : r4[i], send = b4 ? r4[i] : r4[i + 2]; r2[i] = keep + __shfl_xor(send, 16); }
        { const float keep = b3 ? r2[1] : r2[0], send = b3 ? r2[0] : r2[1]; r1_ = keep + __shfl_xor(send, 8); }
        r1_ += __shfl_xor(r1_, 4); r1_ += __shfl_xor(r1_, 2); r1_ += __shfl_xor(r1_, 1);
        ss = wave_sum(ss); const float rs = 1.0f / sqrtf(ss * (1.0f / D) + RMS_EPS);
        float le[8];
#pragma unroll
        for (int e = 0; e < 8; ++e) le[e] = __uint_as_float(__builtin_amdgcn_readlane(__float_as_uint(r1_), 8 * e)) * rs;
        int e1 = 0; float v1 = le[0];
#pragma unroll
        for (int e = 1; e < 8; ++e) if (le[e] > v1) { v1 = le[e]; e1 = e; }
        int e2 = -1; float v2 = -INFINITY;
#pragma unroll
        for (int e = 0; e < 8; ++e) if (e != e1 && le[e] > v2) { v2 = le[e]; e2 = e; }
        if (e2 < 0) e2 = (e1 == 0) ? 1 : 0;
        const float ex = expf(v2 - v1), g1 = 1.0f / (1.0f + ex), g2 = ex * g1;
        if (F.lane == 0) { toke[m] = (unsigned)e1 | ((unsigned)e2 << 8); tokg[2 * m] = g1; tokg[2 * m + 1] = g2; tokr[m] = rs; }
        mycnt += (F.lane == e1) ? 1 : 0; mycnt += (F.lane == e2) ? 1 : 0;
    }
    if (F.lane < 8 && mycnt) __hip_atomic_fetch_add((unsigned*)(Fctl + CW_CNT) + F.lane, (unsigned)mycnt, __ATOMIC_RELAXED, __HIP_MEMORY_SCOPE_AGENT);
    return mycnt;
}
__device__ __forceinline__ int moe_bases(const Frame& F0, int& total) {
    const Frame F = refresh(F0);
    const AS4 Args* A_ = kargs(); gu32* const Fctl = (gu32*)(A_->ws + WS_CTL);
    const unsigned c8 = __hip_atomic_load((unsigned*)(Fctl + CW_CNT) + (F.lane & 7), __ATOMIC_RELAXED, __HIP_MEMORY_SCOPE_AGENT);
    const int rp = (int)((c8 + 255u) & ~255u); int pb = 0, tot = 0;
#pragma unroll
    for (int k = 0; k < 8; ++k) { const int v = __shfl(rp, k); tot += v; if (k < (F.lane & 7)) pb += v; }
    total = tot; return pb;
}
__device__ __forceinline__ void gather_phase(const Frame& F0, int mycnt) {
    const Frame F = refresh(F0);
    const AS4 Args* A_ = kargs(); unsigned char* const Fws = A_->ws; gu32* const Fctl = (gu32*)(Fws + WS_CTL);
    const int gw = F.vcu * NWAVES + F.wave, NGW = F.G * NWAVES, rpw = (M + NGW - 1) / NGW;
    const unsigned* toke = (const unsigned*)(Fws + WS_TOKE); const float* tokr = (const float*)(Fws + WS_TOKR);
    int* pos = (int*)(Fws + WS_POS); float* rsg = (float*)(Fws + WS_RSG);
    const bf16* XB = (const bf16*)(Fws + WS_XB); bf16* XG = (bf16*)(Fws + WS_XG);
    const unsigned* wmaxp = (const unsigned*)((gu32*)(Fws + WS_CTL) + CW_WMAX); float wmax8[8];
#pragma unroll
    for (int e = 0; e < 8; ++e) wmax8[e] = __uint_as_float(wmaxp[64 * e]);
    int total; int wb = moe_bases(F, total);
    if (F.lane < 8 && mycnt) wb += (int)__hip_atomic_fetch_add((unsigned*)(Fctl + CW_CUR) + F.lane, (unsigned)mycnt, __ATOMIC_RELAXED, __HIP_MEMORY_SCOPE_AGENT);
    const int r0 = gw * rpw, r1 = (r0 + rpw < M) ? r0 + rpw : M;
    for (int m = r0; m < r1; ++m) {
        const unsigned ee = toke[m]; const int e1 = (int)(ee & 255u), e2 = (int)(ee >> 8);
        const int s1 = __shfl(wb, e1); if (F.lane == e1) ++wb;
        const int s2 = __shfl(wb, e2); if (F.lane == e2) ++wb;
        const v4u* src = (const v4u*)(XB + (size_t)m * D) + 2 * F.lane; const v4u a = src[0], b = src[1];
        float f[16]; { float t0[8], t1[8]; unpack8(a, t0); unpack8(b, t1);
#pragma unroll
            for (int i = 0; i < 8; ++i) { f[i] = t0[i]; f[8 + i] = t1[i]; } }
        float mx = 0.f;
#pragma unroll
        for (int i = 0; i < 16; ++i) mx = fmaxf(mx, fabsf(f[i]));
#pragma unroll
        for (int o = 1; o < 64; o <<= 1) mx = fmaxf(mx, __shfl_xor(mx, o));
        const float sa = mx > 0.f ? mx * (1.0f / 127.0f) : 1.f, inv = 1.0f / sa; unsigned w[4];
#pragma unroll
        for (int j = 0; j < 4; ++j) { const int q0 = (int)rintf(f[4 * j] * inv), q1 = (int)rintf(f[4 * j + 1] * inv), q2 = (int)rintf(f[4 * j + 2] * inv), q3 = (int)rintf(f[4 * j + 3] * inv);
            w[j] = (unsigned)(q0 & 255) | ((unsigned)(q1 & 255) << 8) | ((unsigned)(q2 & 255) << 16) | ((unsigned)(q3 & 255) << 24); }
        const v4u qv = {w[0], w[1], w[2], w[3]};
        *((v4u*)((unsigned char*)XG + (size_t)s1 * D) + F.lane) = qv; *((v4u*)((unsigned char*)XG + (size_t)s2 * D) + F.lane) = qv;
        if (F.lane == 0) { const float r = tokr[m] * sa * (1.0f / 127.0f); pos[2 * m] = s1; pos[2 * m + 1] = s2; rsg[s1] = r * wmax8[e1]; rsg[s2] = r * wmax8[e2]; }
    }
}
__device__ __forceinline__ void combine_phase(const Frame& F0) {
    const Frame F = refresh(F0);
    const AS4 Args* A_ = kargs(); unsigned char* const Fws = A_->ws; const bf16* xr_ = (const bf16*)(Fws + WS_XB); float* out = A_->out; const float* gfin = A_->in[I_FING];
    const int gw = F.vcu * NWAVES + F.wave, NGW = F.G * NWAVES;
    const float* tokg = (const float*)(Fws + WS_TOKG); const int* pos = (const int*)(Fws + WS_POS); const bf16* Y = (const bf16*)(Fws + WS_XG);
    f32x4 gf[4];
#pragma unroll
    for (int j = 0; j < 4; ++j) gf[j] = ((const f32x4*)gfin)[F.lane + 64 * j];
    for (int m = gw; m < M; m += NGW) {
        const int s1 = pos[2 * m], s2 = pos[2 * m + 1]; const float g1 = tokg[2 * m], g2 = tokg[2 * m + 1];
        const u32x2_t* xr = (const u32x2_t*)(xr_ + (size_t)m * D) + F.lane;
        const u32x2_t* y1 = (const u32x2_t*)(Y + (size_t)s1 * D) + F.lane; const u32x2_t* y2 = (const u32x2_t*)(Y + (size_t)s2 * D) + F.lane;
        f32x4 v[4]; float ss = 0.f;
#pragma unroll
        for (int j = 0; j < 4; ++j) { const u32x2_t xw = xr[64 * j]; const f32x4 xv = {__uint_as_float(xw.x << 16), __uint_as_float(xw.x & 0xffff0000u), __uint_as_float(xw.y << 16), __uint_as_float(xw.y & 0xffff0000u)}; const u32x2_t a = y1[64 * j], b = y2[64 * j];
            v[j][0] = xv[0] + g1 * __uint_as_float(a.x << 16) + g2 * __uint_as_float(b.x << 16);
            v[j][1] = xv[1] + g1 * __uint_as_float(a.x & 0xffff0000u) + g2 * __uint_as_float(b.x & 0xffff0000u);
            v[j][2] = xv[2] + g1 * __uint_as_float(a.y << 16) + g2 * __uint_as_float(b.y << 16);
            v[j][3] = xv[3] + g1 * __uint_as_float(a.y & 0xffff0000u) + g2 * __uint_as_float(b.y & 0xffff0000u);
            ss += (v[j][0] * v[j][0] + v[j][1] * v[j][1]) + (v[j][2] * v[j][2] + v[j][3] * v[j][3]); }
        ss = wave_sum(ss); const float rs = 1.0f / sqrtf(ss * (1.0f / D) + RMS_EPS);
        f32x4* o = (f32x4*)(out + (size_t)m * D) + F.lane;
#pragma unroll
        for (int j = 0; j < 4; ++j) o[64 * j] = v[j] * rs * gf[j];
    }
}

#ifndef ATTN_VARIANT
#define ATTN_VARIANT 3
#endif
#if ATTN_VARIANT == 3
#define ATTN_UNIT attn_unit3
#else
#define ATTN_UNIT attn_unit
#endif
#ifndef PHASE_MASK
#define PHASE_MASK 0xFFFF
#endif
#define PH(b) ((PHASE_MASK >> (b)) & 1)
__global__ void __launch_bounds__(NWAVES * 64, 2) mega_fwd(Args args) {
    extern __shared__ __attribute__((aligned(16))) unsigned char lds[];
    Frame F;
    F.lds = (LAS unsigned char*)lds;
    F.MISC = (volatile LAS unsigned*)(F.lds + MISC_OFF);
    F.tid = threadIdx.x; F.lane = F.tid & 63; F.wave = __builtin_amdgcn_readfirstlane(F.tid >> 6);
    F.G = gridDim.x; { const int bx = blockIdx.x; F.vcu = (F.G % 8 == 0) ? (bx % 8) * (F.G / 8) + bx / 8 : bx; }
    for (int u = F.tid; u < (LDS_BYTES - LDSCTL_OFF) / 4; u += NWAVES * 64) ((LAS unsigned*)(F.lds + LDSCTL_OFF))[u] = 0u;
    __syncthreads();
    XcdBarrier bar = xcd_barrier_post((unsigned*)(args.ws + WS_CTL) + CW_BAR, F.MISC + 8);
#define GRID_BAR() do { XcdBarrier b2_ = bar; b2_.bar = (unsigned*)(kargs()->ws + WS_CTL) + CW_BAR; asm volatile("" : "+s"(b2_.x)); xcd_barrier(b2_); } while (0)
#define PHASE_PTRS() const AS4 Args* ka = kargs(); unsigned char* const ws = ka->ws; bf16* const XB = (bf16*)(ws + WS_XB); float* const XR = ka->out; float* const ssqp = (float*)(ws + WS_SSQP); bf16* const Z = (bf16*)(ws + WS_ARENA); \
    (void)XB; (void)XR; (void)ssqp; (void)Z
    constexpr size_t ZGE = ZG / 2;

    if (PH(0)) p0_prologue(F);
    GRID_BAR();

    { constexpr int l = 0;
        if (PH(1)) { PHASE_PTRS(); pg8::Gemm g{(const bf16*)(ws + WS_XQ), (const bf16*)(ws + WS_WIN + (size_t)l * INW * D), M, INW, D / 2, (const bf16*)(ws + WS_WIN + (size_t)l * INW * D), (const bf16*)(ws + WS_XQ)}; pg8::InProjOrder S; S.init(M, INW, F.G, (int)blockIdx.x);
          constexpr long BHD = (long)WS_SSQP - (long)WS_XS;
          for (int i_ = 0; i_ < 2 * ((int)blockIdx.x >> 6); ++i_) __builtin_amdgcn_s_sleep(63);
          pg8::EpiInProj<BHD> E{Z, ZGE, (const float*)(ws + WS_XS), (const float*)(ws + WS_WCS) + l * INW, C2, (unsigned*)(ws + WS_CTL) + CW_KMAX + l * 32, (F.G == 256 && pg8::WGM == 8 && pg8::NXCD == 8) ? ka->in[I_CONVW] + (size_t)l * 3 * D : (const float*)nullptr};
          pg8::gemm_phase<pg8::EpiInProj<BHD>, pg8::InProjOrder, true, true, true>(F.lds + RING_OFF, g, S, E, F.wave); }
        GRID_BAR();
        if (PH(2)) { conv_phase(F, l); if (l == 0) wq_phase(F); }
        if (PH(3)) { PHASE_PTRS(); const float* par = (const float*)(ws + WS_PAR);
          const float* gsub = ka->in[I_SUBLN] + l * 128; const float* relb = ka->in[I_RELB];
#ifdef PROBE_ATTN2
          for (int rep_ = 0; rep_ < 2; ++rep_) {
#else
          {
#endif
          { const int nun = (F.G == 256) ? 8 : (2048 - F.vcu + F.G - 1) / F.G;
#pragma unroll 1
              for (int r = 0; r < nun; ++r) { int bh, qb;
                  if (F.G == 256) { const int c = F.vcu & 15; bh = F.vcu >> 4; qb = 16 * r + ((r & 1) ? 15 - c : c); } else { const int L = F.vcu + r * F.G; bh = L >> 7; qb = L & 127; }
                  dattn::ATTN_UNIT(bh >> 3, bh & 7, qb, Z, Z + ZGE, Z + 2 * ZGE, Z, relb, par, l, gsub, (char*)lds + RING_OFF, F.wave, (const unsigned*)(ws + WS_CTL) + CW_KMAX + l * 32 + (bh >> 3) * 16);     } }
          }
          asm volatile("s_waitcnt vmcnt(0) lgkmcnt(0)\n\ts_barrier" ::: "memory"); }
        GRID_BAR();
        if (PH(4)) { PHASE_PTRS(); pg8::Gemm g{Z, (const bf16*)(ws + WS_WSM) + (size_t)(l * 3 + 0) * D * D, M, D, D, Z + 4 * ZGE, (const bf16*)(ws + WS_WSM) + (size_t)(l * 3 + 1) * D * D};
          pg8::PairOrder S; S.init(M, D, F.G, (int)blockIdx.x);
          pg8::EpiGateFused E{(const unsigned char*)(Z + 6 * ZGE), (const unsigned char*)(Z + 7 * ZGE), Z + 5 * ZGE};
          pg8::gemm_phase<pg8::EpiGateFused, pg8::PairOrder, true, true>(F.lds + RING_OFF, g, S, E, F.wave); }
        GRID_BAR();
        if (PH(6)) { PHASE_PTRS(); pg8::Gemm g{Z + 5 * ZGE, (const bf16*)(ws + WS_WSM) + (size_t)(l * 3 + 2) * D * D, M, D, D}; pg8::StaticOrder S; S.init(M, D, F.G, (int)blockIdx.x);
          pg8::EpiResid<l == 0> E{ka->in[I_X], XB, 1.f};
          pg8::gemm_phase<pg8::EpiResid<l == 0>, pg8::StaticOrder, true, true>(F.lds + RING_OFF, g, S, E, F.wave); }
        GRID_BAR();
        if (l == 0) {
            rowquant_phase(F);
            GRID_BAR();
            if (PH(7)) { PHASE_PTRS(); pg8::Gemm g{(const bf16*)(ws + WS_XQ), (const bf16*)(ws + WS_WGU), M, 2 * FFD, D / 2}; pg8::StaticOrder S; S.init(M, 2 * FFD, F.G, (int)blockIdx.x);
              pg8::EpiSwiGLU<pg8::RowScaleDirect, true, true> E{(bf16*)(ws + WS_HD), FFD, pg8::RowScaleDirect{(const float*)(ws + WS_XS)}, (const float*)(ws + WS_GCS), H8_SCALE};
              pg8::gemm_phase<pg8::EpiSwiGLU<pg8::RowScaleDirect, true, true>, pg8::StaticOrder, true, true, true>(F.lds + RING_OFF, g, S, E, F.wave); }
            GRID_BAR();
            if (PH(8)) { PHASE_PTRS(); pg8::Gemm g{(const bf16*)(ws + WS_HD), (const bf16*)(ws + WS_WDN), M, D, FFD / 2}; pg8::StaticOrder S; S.init(M, D, F.G, (int)blockIdx.x);
              pg8::EpiResid<false> E{nullptr, XB, 1.0f / (H8_SCALE * WD8_SCALE)};
              pg8::gemm_phase<pg8::EpiResid<false>, pg8::StaticOrder, true, true, false, true>(F.lds + RING_OFF, g, S, E, F.wave); }
            GRID_BAR();
            rowquant_phase(F);
            GRID_BAR();
        } else {
            const int mycnt = PH(9) ? router_phase(F) : 0;
            GRID_BAR();
            if (PH(10)) gather_phase(F, mycnt);
            GRID_BAR();
            if (PH(11)) { PHASE_PTRS(); int total; const int pb = moe_bases(F, total); const int npan = __builtin_amdgcn_readfirstlane(total) >> 8;
              pg8::Gemm g{(const bf16*)(ws + WS_XG), (const bf16*)(ws + WS_WEGU), SLOTS, 2 * FFE, D / 2}; pg8::MoeOrder S; S.init(npan, 2 * FFE, F.G, (int)blockIdx.x, 2 * FFE);
#pragma unroll
              for (int k = 0; k < 8; ++k) S.ps[k] = __builtin_amdgcn_readfirstlane(__shfl(pb, k)) >> 8;
              pg8::EpiSwiGLU<pg8::RowScaleDirect, false, true> E{(bf16*)(ws + WS_HE), FFE, pg8::RowScaleDirect{(const float*)(ws + WS_RSG)}, nullptr, H8_SCALE};
              pg8::gemm_phase<pg8::EpiSwiGLU<pg8::RowScaleDirect, false, true>, pg8::MoeOrder, true, true, true>(F.lds + RING_OFF, g, S, E, F.wave); }
            GRID_BAR();
            if (PH(12)) { PHASE_PTRS(); int total; const int pb = moe_bases(F, total); const int npan = __builtin_amdgcn_readfirstlane(total) >> 8;
              pg8::Gemm g{(const bf16*)(ws + WS_HE), (const bf16*)(ws + WS_WEDN), SLOTS, D, FFE / 2}; pg8::MoeOrder S; S.init(npan, D, F.G, (int)blockIdx.x, D);
#pragma unroll
              for (int k = 0; k < 8; ++k) S.ps[k] = __builtin_amdgcn_readfirstlane(__shfl(pb, k)) >> 8;
              pg8::EpiPlainBf16 E{(bf16*)(ws + WS_XG), D, 1.0f / (H8_SCALE * WD8_SCALE)};
              pg8::gemm_phase<pg8::EpiPlainBf16, pg8::MoeOrder, true, true, false, true>(F.lds + RING_OFF, g, S, E, F.wave); }
            GRID_BAR();
            if (PH(13)) combine_phase(F);
        }
        }
    { constexpr int l = 1;
        if (PH(1)) { PHASE_PTRS(); pg8::Gemm g{(const bf16*)(ws + WS_XQ), (const bf16*)(ws + WS_WIN + (size_t)l * INW * D), M, INW, D / 2, (const bf16*)(ws + WS_WIN + (size_t)l * INW * D), (const bf16*)(ws + WS_XQ)}; pg8::InProjOrder S; S.init(M, INW, F.G, (int)blockIdx.x);
          constexpr long BHD = (long)WS_SSQP - (long)WS_XS;
          for (int i_ = 0; i_ < 2 * ((int)blockIdx.x >> 6); ++i_) __builtin_amdgcn_s_sleep(63);
          pg8::EpiInProj<BHD> E{Z, ZGE, (const float*)(ws + WS_XS), (const float*)(ws + WS_WCS) + l * INW, C2, (unsigned*)(ws + WS_CTL) + CW_KMAX + l * 32, (F.G == 256 && pg8::WGM == 8 && pg8::NXCD == 8) ? ka->in[I_CONVW] + (size_t)l * 3 * D : (const float*)nullptr};
          pg8::gemm_phase<pg8::EpiInProj<BHD>, pg8::InProjOrder, true, true, true>(F.lds + RING_OFF, g, S, E, F.wave); }
        GRID_BAR();
        if (PH(2)) { conv_phase(F, l); if (l == 0) wq_phase(F); }
        if (PH(3)) { PHASE_PTRS(); const float* par = (const float*)(ws + WS_PAR);
          const float* gsub = ka->in[I_SUBLN] + l * 128; const float* relb = ka->in[I_RELB];
#ifdef PROBE_ATTN2
          for (int rep_ = 0; rep_ < 2; ++rep_) {
#else
          {
#endif
          { const int nun = (F.G == 256) ? 8 : (2048 - F.vcu + F.G - 1) / F.G;
#pragma unroll 1
              for (int r = 0; r < nun; ++r) { int bh, qb;
                  if (F.G == 256) { const int c = F.vcu & 15; bh = F.vcu >> 4; qb = 16 * r + ((r & 1) ? 15 - c : c); } else { const int L = F.vcu + r * F.G; bh = L >> 7; qb = L & 127; }
                  dattn::ATTN_UNIT(bh >> 3, bh & 7, qb, Z, Z + ZGE, Z + 2 * ZGE, Z, relb, par, l, gsub, (char*)lds + RING_OFF, F.wave, (const unsigned*)(ws + WS_CTL) + CW_KMAX + l * 32 + (bh >> 3) * 16);     } }
          }
          asm volatile("s_waitcnt vmcnt(0) lgkmcnt(0)\n\ts_barrier" ::: "memory"); }
        GRID_BAR();
        if (PH(4)) { PHASE_PTRS(); pg8::Gemm g{Z, (const bf16*)(ws + WS_WSM) + (size_t)(l * 3 + 0) * D * D, M, D, D, Z + 4 * ZGE, (const bf16*)(ws + WS_WSM) + (size_t)(l * 3 + 1) * D * D};
          pg8::PairOrder S; S.init(M, D, F.G, (int)blockIdx.x);
          pg8::EpiGateFused E{(const unsigned char*)(Z + 6 * ZGE), (const unsigned char*)(Z + 7 * ZGE), Z + 5 * ZGE};
          pg8::gemm_phase<pg8::EpiGateFused, pg8::PairOrder, true, true>(F.lds + RING_OFF, g, S, E, F.wave); }
        GRID_BAR();
        if (PH(6)) { PHASE_PTRS(); pg8::Gemm g{Z + 5 * ZGE, (const bf16*)(ws + WS_WSM) + (size_t)(l * 3 + 2) * D * D, M, D, D}; pg8::StaticOrder S; S.init(M, D, F.G, (int)blockIdx.x);
          pg8::EpiResid<l == 0> E{ka->in[I_X], XB, 1.f};
          pg8::gemm_phase<pg8::EpiResid<l == 0>, pg8::StaticOrder, true, true>(F.lds + RING_OFF, g, S, E, F.wave); }
        GRID_BAR();
        if (l == 0) {
            rowquant_phase(F);
            GRID_BAR();
            if (PH(7)) { PHASE_PTRS(); pg8::Gemm g{(const bf16*)(ws + WS_XQ), (const bf16*)(ws + WS_WGU), M, 2 * FFD, D / 2}; pg8::StaticOrder S; S.init(M, 2 * FFD, F.G, (int)blockIdx.x);
              pg8::EpiSwiGLU<pg8::RowScaleDirect, true, true> E{(bf16*)(ws + WS_HD), FFD, pg8::RowScaleDirect{(const float*)(ws + WS_XS)}, (const float*)(ws + WS_GCS), H8_SCALE};
              pg8::gemm_phase<pg8::EpiSwiGLU<pg8::RowScaleDirect, true, true>, pg8::StaticOrder, true, true, true>(F.lds + RING_OFF, g, S, E, F.wave); }
            GRID_BAR();
            if (PH(8)) { PHASE_PTRS(); pg8::Gemm g{(const bf16*)(ws + WS_HD), (const bf16*)(ws + WS_WDN), M, D, FFD / 2}; pg8::StaticOrder S; S.init(M, D, F.G, (int)blockIdx.x);
              pg8::EpiResid<false> E{nullptr, XB, 1.0f / (H8_SCALE * WD8_SCALE)};
              pg8::gemm_phase<pg8::EpiResid<false>, pg8::StaticOrder, true, true, false, true>(F.lds + RING_OFF, g, S, E, F.wave); }
            GRID_BAR();
            rowquant_phase(F);
            GRID_BAR();
        } else {
            const int mycnt = PH(9) ? router_phase(F) : 0;
            GRID_BAR();
            if (PH(10)) gather_phase(F, mycnt);
            GRID_BAR();
            if (PH(11)) { PHASE_PTRS(); int total; const int pb = moe_bases(F, total); const int npan = __builtin_amdgcn_readfirstlane(total) >> 8;
              pg8::Gemm g{(const bf16*)(ws + WS_XG), (const bf16*)(ws + WS_WEGU), SLOTS, 2 * FFE, D / 2}; pg8::MoeOrder S; S.init(npan, 2 * FFE, F.G, (int)blockIdx.x, 2 * FFE);
#pragma unroll
              for (int k = 0; k < 8; ++k) S.ps[k] = __builtin_amdgcn_readfirstlane(__shfl(pb, k)) >> 8;
              pg8::EpiSwiGLU<pg8::RowScaleDirect, false, true> E{(bf16*)(ws + WS_HE), FFE, pg8::RowScaleDirect{(const float*)(ws + WS_RSG)}, nullptr, H8_SCALE};
              pg8::gemm_phase<pg8::EpiSwiGLU<pg8::RowScaleDirect, false, true>, pg8::MoeOrder, true, true, true>(F.lds + RING_OFF, g, S, E, F.wave); }
            GRID_BAR();
            if (PH(12)) { PHASE_PTRS(); int total; const int pb = moe_bases(F, total); const int npan = __builtin_amdgcn_readfirstlane(total) >> 8;
              pg8::Gemm g{(const bf16*)(ws + WS_HE), (const bf16*)(ws + WS_WEDN), SLOTS, D, FFE / 2}; pg8::MoeOrder S; S.init(npan, D, F.G, (int)blockIdx.x, D);
#pragma unroll
              for (int k = 0; k < 8; ++k) S.ps[k] = __builtin_amdgcn_readfirstlane(__shfl(pb, k)) >> 8;
              pg8::EpiPlainBf16 E{(bf16*)(ws + WS_XG), D, 1.0f / (H8_SCALE * WD8_SCALE)};
              pg8::gemm_phase<pg8::EpiPlainBf16, pg8::MoeOrder, true, true, false, true>(F.lds + RING_OFF, g, S, E, F.wave); }
            GRID_BAR();
            if (PH(13)) combine_phase(F);
        }
        }
#undef GRID_BAR
#undef PHASE_PTRS
}

extern "C" void kernel_launch(void* const* d_in, const int* in_sizes, int n_in, void* d_out, int out_size, void* d_ws, size_t ws_size, hipStream_t stream) {
    static int grid = 0;
    if (grid == 0) {
        if (n_in != 17 || in_sizes[0] != M * D || out_size != M * D || ws_size < WS_END) { fprintf(stderr, "kernel_launch: shape/workspace mismatch: n_in %d in0 %d out %d ws %zu (need %zu)\n", n_in, n_in > 0 ? in_sizes[0] : -1, out_size, ws_size, (size_t)WS_END); grid = -1; return; }
        int dev = 0, cus = 0, per_cu = 0;
        if (hipGetDevice(&dev) != hipSuccess || hipDeviceGetAttribute(&cus, hipDeviceAttributeMultiprocessorCount, dev) != hipSuccess) { grid = -1; return; }
        if (hipFuncSetAttribute((const void*)mega_fwd, hipFuncAttributeMaxDynamicSharedMemorySize, LDS_BYTES) != hipSuccess) { fprintf(stderr, "kernel_launch: hipFuncSetAttribute failed\n"); grid = -1; return; }
        if (hipOccupancyMaxActiveBlocksPerMultiprocessor(&per_cu, (const void*)mega_fwd, NWAVES * 64, LDS_BYTES) != hipSuccess || per_cu < 1) { fprintf(stderr, "kernel_launch: occupancy query reports %d\n", per_cu); }
        (void)hipGetLastError();
        grid = cus;
    }
    if (grid < 0) return;
    if (hipMemsetAsync((char*)d_ws + WS_CTL, 0, CTL_ZERO_BYTES, stream) != hipSuccess) return;
    Args a{};
    for (int i = 0; i < 17; ++i) a.in[i] = (const float*)d_in[i];
    a.out = (float*)d_out; a.ws = (unsigned char*)d_ws;
    hipLaunchKernelGGL(mega_fwd, dim3(grid), dim3(NWAVES * 64), LDS_BYTES, stream, a);
    const hipError_t le = hipPeekAtLastError();
    if (le != hipSuccess) fprintf(stderr, "kernel_launch: launch failed: %s\n", hipGetErrorName(le));
}
```

```cpp
#include <hip/hip_runtime.h>
#include <hip/hip_bf16.h>
#include <cstdio>
#include <cstdint>
#include <cmath>

#ifndef MK_N_LAUNCHES
#define MK_N_LAUNCHES 1
#endif

namespace pg8 {
#define PG8_LAS __attribute__((address_space(3)))
typedef unsigned short bf16_t;
typedef short bf16x8 __attribute__((ext_vector_type(8)));
typedef float f32x4 __attribute__((ext_vector_type(4)));
typedef unsigned u32x4 __attribute__((ext_vector_type(4)));
typedef unsigned u32x2 __attribute__((ext_vector_type(2)));
constexpr int BM = 256, BK = 64, HALF = 128, HTB = HALF * BK * 2  , STAGE_BYTES = 8 * HTB, NXCD = 8, WGM = 8;

__host__ __device__ __forceinline__ int lds_byte(int r, int c) { const int st = (r >> 4) * 2 + (c >> 5), rr = r & 15, cc = c & 31, ob = rr * 64 + cc * 2; return st * 1024 + (ob ^ (((ob >> 9) & 1) << 5)); }
__host__ __device__ __forceinline__ void stage_rc(int b, int& R, int& C) { const int st = b / 1024, sb = b % 1024, swz = sb ^ (((sb >> 9) & 1) << 5); R = (st >> 1) * 16 + swz / 64; C = (st & 1) * 32 + (swz % 64) / 2; }
__host__ __device__ __forceinline__ int perm32(int rho) { const int n = rho >> 4, i = rho & 15; return 8 * (i >> 2) + 4 * n + (i & 3); }

struct Unit { int pm, pn, be, seg; };
struct Gemm { const bf16_t* A; const bf16_t* Bt; int M, N, K; const bf16_t* A2; const bf16_t* Bt2; };

struct StaticOrder {
    int nM, nN, nwg, G, c;
    __host__ __device__ void init(int M, int N, int G_, int c_) { nM = M / BM; nN = N / BM; nwg = nM * nN; G = G_; c = c_; }
    __host__ __device__ bool next(int i, Unit& u) const {
        const long L = (long)i * G + c; if (L >= nwg) return false;
        int wgid = (int)L; { const int q = nwg / NXCD, r = nwg % NXCD, xcd = wgid % NXCD, off = wgid / NXCD; wgid = (xcd < r ? xcd * (q + 1) : r * (q + 1) + (xcd - r) * q) + off; }
        const int nig = WGM * nN, gid = wgid / nig, fm = gid * WGM, gsz = (nM - fm) < WGM ? (nM - fm) : WGM;
        u.pm = fm + ((wgid % nig) % gsz); u.pn = (wgid % nig) / gsz; u.be = 0; u.seg = 0; return true;
    }
    __device__ __forceinline__ void a_ready(const Unit&) const {}
    __device__ __forceinline__ void done(const Unit&) const {}
};
struct PairOrder {
    StaticOrder so;
    __device__ __forceinline__ void init(int M, int N, int G_, int c_) { so.init(M, N, G_, c_); }
    __device__ __forceinline__ bool next(int i, Unit& u) const { if (!so.next(i >> 1, u)) return false; u.seg = i & 1; return true; }
    __device__ __forceinline__ void a_ready(const Unit&) const {}
    __device__ __forceinline__ void done(const Unit&) const {}
};
struct InProjOrder {
    StaticOrder so;
    __device__ __forceinline__ void init(int M, int N, int G_, int c_) { so.init(M, N, G_, c_); }
    __device__ __forceinline__ bool next(int i, Unit& u) const { if (!so.next(i, u)) return false; if (u.pn >= 8 && u.pn < 12) { const int t = u.pm; u.pm = u.pn; u.pn = t; u.seg = 1; } return true; }
    __device__ __forceinline__ void a_ready(const Unit&) const {}
    __device__ __forceinline__ void done(const Unit&) const {}
};
struct MoeOrder {
    int nM, nN, nwg, G, c, erows; int ps[8];
    __device__ __forceinline__ void init(int npan, int N, int G_, int c_, int erows_) { nM = npan; nN = N / BM; nwg = nM * nN; G = G_; c = c_; erows = erows_; }
    __device__ __forceinline__ bool next(int i, Unit& u) const {
        const long L = (long)i * G + c; if (L >= nwg) return false;
        int wgid = (int)L; { const int q = nwg / NXCD, r = nwg % NXCD, xcd = wgid % NXCD, off = wgid / NXCD; wgid = (xcd < r ? xcd * (q + 1) : r * (q + 1) + (xcd - r) * q) + off; }
        const int nig = WGM * nN, gid = wgid / nig, fm = gid * WGM, gsz = (nM - fm) < WGM ? (nM - fm) : WGM;
        u.pm = fm + ((wgid % nig) % gsz); u.pn = (wgid % nig) / gsz;
        int e = 0;
#pragma unroll
        for (int k = 1; k < 8; ++k) e += (u.pm >= ps[k]) ? 1 : 0;
        u.be = e * erows; u.seg = 0; return true;
    }
    __device__ __forceinline__ void a_ready(const Unit&) const {}
    __device__ __forceinline__ void done(const Unit&) const {}
};

__device__ __forceinline__ unsigned cvt_pk_bf16(float lo, float hi) { unsigned r; asm volatile("v_cvt_pk_bf16_f32 %0, %1, %2" : "=v"(r) : "v"(lo), "v"(hi)); return r; }
__device__ __forceinline__ float bf_lo(unsigned w) { return __uint_as_float(w << 16); }
__device__ __forceinline__ float bf_hi(unsigned w) { return __uint_as_float(w & 0xffff0000u); }
__device__ __forceinline__ float sigmoidf_(float x) { return __builtin_amdgcn_rcpf(1.f + __builtin_amdgcn_exp2f(-1.4426950408889634f * x)); }
__device__ __forceinline__ u32x4 pack8(const f32x4 a, const f32x4 b) { u32x4 w; w.x = cvt_pk_bf16(a[0], a[1]); w.y = cvt_pk_bf16(a[2], a[3]); w.z = cvt_pk_bf16(b[0], b[1]); w.w = cvt_pk_bf16(b[2], b[3]); return w; }

__device__ __forceinline__ unsigned pack4_fp8(float a, float b, float c, float d) { unsigned w = 0; w = __builtin_amdgcn_cvt_pk_fp8_f32(a, b, w, false); w = __builtin_amdgcn_cvt_pk_fp8_f32(c, d, w, true); return w; }
struct RowScaleP16 { const float* p;
    __device__ __forceinline__ float get(int row, int fq) const { const f32x4 a = ((const f32x4*)(p + (size_t)row * 16))[fq];
        float s = (a[0] + a[1]) + (a[2] + a[3]); s += __shfl_xor(s, 16); s += __shfl_xor(s, 32);
        return __builtin_amdgcn_rsqf(s * (1.0f / 1024.0f) + 1e-6f); } };
struct RowScaleDirect { const float* rs; __device__ __forceinline__ float get(int row, int) const { return rs[row]; } };

template <long BHD> struct EpiInProj {
    static constexpr bool PERM = true, AFTER_DRAIN = false, HAS_MID = false;
    bf16_t* Z; size_t gstride; const float* xs; const float* wcs; float qscale; unsigned* kmax; const float* cw;
    __device__ __forceinline__ void operator()(const f32x4 (&acc)[2][2][4][2], const Unit& u, int wr, int wc, int fr, int fq) const {
        const int row0 = u.pm * BM + wr * 64 + fr; f32x4 cs[2][2]; float s8[2][4];
        const bool vt = u.seg != 0;
        const bool uc = !vt && (u.pn >= 12 && u.pn < 20);
        const int grp = vt ? 2 : u.pn < 12 ? (u.pn >> 2) : uc ? 3 : u.pn < 24 ? 4 : u.pn < 28 ? 6 : 7; const bool sig = grp >= 6;
        const float gs = (grp == 0) ? qscale : 1.f;
        const float* rsc = vt ? wcs : xs; const float* csc = vt ? xs : wcs;
#pragma unroll
        for (int ai = 0; ai < 2; ++ai)
#pragma unroll
            for (int m = 0; m < 4; ++m) s8[ai][m] = rsc[row0 + ai * HALF + m * 16];
#pragma unroll
        for (int bj = 0; bj < 2; ++bj)
#pragma unroll
            for (int n = 0; n < 2; ++n) cs[bj][n] = *(const f32x4*)(csc + u.pn * BM + bj * HALF + wc * 32 + 8 * fq + 4 * n) * gs;
        bf16_t* base = Z + (size_t)grp * gstride;
        if (vt) {
            constexpr int VT_SEQ = 16384;
            const int tok0 = u.pn * BM + wc * 32 + 16 * (fq >> 1) + 4 * (fq & 1); bf16_t* vb = base + (size_t)(tok0 / VT_SEQ) * 1024 * VT_SEQ + (tok0 & (VT_SEQ - 1));
#pragma unroll
            for (int ai = 0; ai < 2; ++ai)
#pragma unroll
                for (int m = 0; m < 4; ++m) { const int ch = row0 + ai * HALF + m * 16 - 2048; const float s = s8[ai][m]; bf16_t* rp = vb + (size_t)ch * VT_SEQ;
#pragma unroll
                    for (int bj = 0; bj < 2; ++bj) { const f32x4 v0 = acc[ai][bj][m][0] * s * cs[bj][0], v1 = acc[ai][bj][m][1] * s * cs[bj][1]; u32x2 w0, w1;
                        w0.x = cvt_pk_bf16(v0[0], v0[1]); w0.y = cvt_pk_bf16(v0[2], v0[3]); w1.x = cvt_pk_bf16(v1[0], v1[1]); w1.y = cvt_pk_bf16(v1[2], v1[3]);
                        *(u32x2*)(rp + bj * HALF) = w0; *(u32x2*)(rp + bj * HALF + 8) = w1; } }
            return; }
        if (uc) { const int col0 = (u.pn - 12) * HALF + wc * 32 + 8 * fq;
#pragma unroll
            for (int ai = 0; ai < 2; ++ai)
#pragma unroll
                for (int m = 0; m < 4; ++m) { const int row = row0 + ai * HALF + m * 16; const float s = s8[ai][m]; f32x4 uu[2];
#pragma unroll
                    for (int n = 0; n < 2; ++n) uu[n] = (acc[ai][0][m][n] * s * cs[0][n]) * (acc[ai][1][m][n] * s * cs[1][n]);
                    *(u32x4*)(base + (size_t)row * 1024 + col0) = pack8(uu[0], uu[1]); }
            return; }
        if (!vt && u.pn >= 20 && u.pn < 24) {
            const int g_ = u.pn - 20; const bf16_t* ug = Z + 3 * gstride; bf16_t* bh = (bf16_t*)((char*)const_cast<float*>(xs) + BHD); const bool fuse = cw != nullptr;
            int fqo = fq, fro = row0; asm volatile("" : "+v"(fqo), "+v"(fro));
#pragma unroll
            for (int bj = 0; bj < 2; ++bj)
#pragma unroll
                for (int n = 0; n < 2; ++n) { const int ch0 = HALF * (g_ + 4 * bj) + wc * 32 + 8 * fqo + 4 * n;
                    if (!fuse) {
#pragma unroll
                        for (int ai = 0; ai < 2; ++ai)
#pragma unroll
                            for (int m = 0; m < 4; ++m) { const int row = fro + ai * HALF + m * 16; const f32x4 v = acc[ai][bj][m][n] * s8[ai][m] * cs[bj][n];
                                u32x2 w; w.x = cvt_pk_bf16(v[0], v[1]); w.y = cvt_pk_bf16(v[2], v[3]); *(u32x2*)(base + (size_t)row * 1024 + ch0) = w; }
                    } else {
                        const f32x4 w0 = *(const f32x4*)(cw + ch0), w1 = *(const f32x4*)(cw + 1024 + ch0), w2 = *(const f32x4*)(cw + 2048 + ch0);
#pragma unroll
                        for (int ai = 0; ai < 2; ++ai)
#pragma unroll
                            for (int m = 0; m < 4; ++m) { const int row = fro + ai * HALF + m * 16; const f32x4 v = acc[ai][bj][m][n] * s8[ai][m] * cs[bj][n];
                                const u32x2 ua = *(const u32x2*)(ug + (size_t)row * 1024 + ch0), ub = *(const u32x2*)(ug + (size_t)(row - 1) * 1024 + ch0), uc_ = *(const u32x2*)(ug + (size_t)(row - 2) * 1024 + ch0);
                                const f32x4 a0 = {bf_lo(ua.x), bf_hi(ua.x), bf_lo(ua.y), bf_hi(ua.y)}, b0 = {bf_lo(ub.x), bf_hi(ub.x), bf_lo(ub.y), bf_hi(ub.y)}, c0 = {bf_lo(uc_.x), bf_hi(uc_.x), bf_lo(uc_.y), bf_hi(uc_.y)};
                                const bool head = (row & 255) < 2; const f32x4 r = head ? v : v * (w0 * c0 + w1 * b0 + w2 * a0);
                                bf16_t* dst = head ? bh + (size_t)((row >> 8) * 2 + (row & 255)) * 1024 + ch0 : base + (size_t)row * 1024 + ch0;
                                u32x2 w; w.x = cvt_pk_bf16(r[0], r[1]); w.y = cvt_pk_bf16(r[2], r[3]); *(u32x2*)dst = w; } } }
            return; }
        const int col0 = (u.pn & 3) * BM + wc * 32 + 8 * fq; float km[2] = {0.f, 0.f};
#pragma unroll
        for (int ai = 0; ai < 2; ++ai)
#pragma unroll
            for (int m = 0; m < 4; ++m) { const int row = row0 + ai * HALF + m * 16; const float s = s8[ai][m]; bf16_t* rowp = base + (size_t)row * 1024 + col0;
#pragma unroll
                for (int bj = 0; bj < 2; ++bj) { f32x4 v0 = acc[ai][bj][m][0] * s * cs[bj][0], v1 = acc[ai][bj][m][1] * s * cs[bj][1];
                    if (grp == 1) km[bj] = fmaxf(fmaxf(fmaxf(km[bj], fmaxf(fabsf(v0[0]), fabsf(v0[1]))), fmaxf(fabsf(v0[2]), fabsf(v0[3]))), fmaxf(fmaxf(fabsf(v1[0]), fabsf(v1[1])), fmaxf(fabsf(v1[2]), fabsf(v1[3]))));
                    if (sig) {
                        unsigned b0 = 0, b1 = 0;
#pragma unroll
                        for (int i = 0; i < 4; ++i) { b0 |= (unsigned)__builtin_rintf(sigmoidf_(v0[i]) * 255.f) << (8 * i); b1 |= (unsigned)__builtin_rintf(sigmoidf_(v1[i]) * 255.f) << (8 * i); }
                        u32x2 w; w.x = b0; w.y = b1; *(u32x2*)((unsigned char*)base + (size_t)row * 1024 + col0 + bj * HALF) = w; }
                    else *(u32x4*)(rowp + bj * HALF) = pack8(v0, v1); } }
        if (grp == 1) {
#pragma unroll
            for (int bj = 0; bj < 2; ++bj) { float v = km[bj];
#pragma unroll
                for (int sft = 32; sft >= 1; sft >>= 1) v = fmaxf(v, __shfl_xor(v, sft));
                if (fr == 0 && fq == 0) atomicMax(kmax + ((u.pm >> 6) * 16 + ((u.pn & 3) * 2 + bj) * 2 + (wc >> 1)), __float_as_uint(v)); } }
    }
};
__device__ __forceinline__ f32x4 ub4(unsigned w) { return (f32x4){(float)(w & 255u), (float)((w >> 8) & 255u), (float)((w >> 16) & 255u), (float)(w >> 24)} * (1.0f / 255.0f); }
struct EpiGateFused {
    static constexpr bool PERM = true, AFTER_DRAIN = false, HAS_MID = true;
    const unsigned char* Ga8; const unsigned char* Gc8; bf16_t* P;
    __device__ __forceinline__ static f32x4 gcl(unsigned w) { const f32x4 g = ub4(w); return (f32x4){fmaxf(g[0], 0.5f / 255.f), fmaxf(g[1], 0.5f / 255.f), fmaxf(g[2], 0.5f / 255.f), fmaxf(g[3], 0.5f / 255.f)}; }
    __device__ __forceinline__ void mid(f32x4 (&acc)[2][2][4][2], const Unit& u, int wr, int wc, int fr, int fq) const {
        const int col0 = u.pn * BM + wc * 32 + 8 * fq, row0 = u.pm * BM + wr * 64 + fr;
#pragma unroll
        for (int ai = 0; ai < 2; ++ai) { u32x2 ga[4][2], gc[4][2];
#pragma unroll
            for (int m = 0; m < 4; ++m)
#pragma unroll
                for (int bj = 0; bj < 2; ++bj) { const size_t off = (size_t)(row0 + ai * HALF + m * 16) * 1024 + col0 + bj * HALF; ga[m][bj] = *(const u32x2*)(Ga8 + off); gc[m][bj] = *(const u32x2*)(Gc8 + off); }
#pragma unroll
            for (int m = 0; m < 4; ++m)
#pragma unroll
                for (int bj = 0; bj < 2; ++bj) { const f32x4 c0 = gcl(gc[m][bj].x), c1 = gcl(gc[m][bj].y);
                    const f32x4 r0 = ub4(ga[m][bj].x) * (f32x4){__builtin_amdgcn_rcpf(c0[0]), __builtin_amdgcn_rcpf(c0[1]), __builtin_amdgcn_rcpf(c0[2]), __builtin_amdgcn_rcpf(c0[3])};
                    const f32x4 r1 = ub4(ga[m][bj].y) * (f32x4){__builtin_amdgcn_rcpf(c1[0]), __builtin_amdgcn_rcpf(c1[1]), __builtin_amdgcn_rcpf(c1[2]), __builtin_amdgcn_rcpf(c1[3])};
                    acc[ai][bj][m][0] = acc[ai][bj][m][0] * r0; acc[ai][bj][m][1] = acc[ai][bj][m][1] * r1; } }
    }
    __device__ __forceinline__ void operator()(const f32x4 (&acc)[2][2][4][2], const Unit& u, int wr, int wc, int fr, int fq) const {
        const int col0 = u.pn * BM + wc * 32 + 8 * fq, row0 = u.pm * BM + wr * 64 + fr;
        u32x2 gc[2][4][2];
#pragma unroll
        for (int ai = 0; ai < 2; ++ai)
#pragma unroll
            for (int m = 0; m < 4; ++m)
#pragma unroll
                for (int bj = 0; bj < 2; ++bj) gc[ai][m][bj] = *(const u32x2*)(Gc8 + (size_t)(row0 + ai * HALF + m * 16) * 1024 + col0 + bj * HALF);
#pragma unroll
        for (int ai = 0; ai < 2; ++ai)
#pragma unroll
            for (int m = 0; m < 4; ++m) { const size_t off = (size_t)(row0 + ai * HALF + m * 16) * 1024 + col0;
#pragma unroll
                for (int bj = 0; bj < 2; ++bj) *(u32x4*)(P + off + bj * HALF) = pack8(gcl(gc[ai][m][bj].x) * acc[ai][bj][m][0], gcl(gc[ai][m][bj].y) * acc[ai][bj][m][1]); }
    }
};
struct EpiGateA {
    static constexpr bool PERM = true, AFTER_DRAIN = false, HAS_MID = false;
    const unsigned char* G8; bf16_t* P;
    __device__ __forceinline__ void operator()(const f32x4 (&acc)[2][2][4][2], const Unit& u, int wr, int wc, int fr, int fq) const {
        const int col0 = u.pn * BM + wc * 32 + 8 * fq, row0 = u.pm * BM + wr * 64 + fr;
#pragma unroll
        for (int ai = 0; ai < 2; ++ai)
#pragma unroll
            for (int m = 0; m < 4; ++m) { const size_t off = (size_t)(row0 + ai * HALF + m * 16) * 1024 + col0;
#pragma unroll
                for (int bj = 0; bj < 2; ++bj) { const u32x2 g = *(const u32x2*)(G8 + off + bj * HALF);
                    *(u32x4*)(P + off + bj * HALF) = pack8(ub4(g.x) * acc[ai][bj][m][0], ub4(g.y) * acc[ai][bj][m][1]); } }
    }
};
struct EpiGateB {
    static constexpr bool PERM = true, AFTER_DRAIN = false, HAS_MID = false;
    bf16_t* P; const unsigned char* Gc8;
    __device__ __forceinline__ void operator()(const f32x4 (&acc)[2][2][4][2], const Unit& u, int wr, int wc, int fr, int fq) const {
        const int col0 = u.pn * BM + wc * 32 + 8 * fq, row0 = u.pm * BM + wr * 64 + fr;
#pragma unroll
        for (int ai = 0; ai < 2; ++ai)
#pragma unroll
            for (int m = 0; m < 4; ++m) { const size_t off = (size_t)(row0 + ai * HALF + m * 16) * 1024 + col0;
#pragma unroll
                for (int bj = 0; bj < 2; ++bj) { const u32x4 p = *(const u32x4*)(P + off + bj * HALF); const u32x2 g = *(const u32x2*)(Gc8 + off + bj * HALF);
                    const f32x4 p0 = {bf_lo(p.x), bf_hi(p.x), bf_lo(p.y), bf_hi(p.y)}, p1 = {bf_lo(p.z), bf_hi(p.z), bf_lo(p.w), bf_hi(p.w)};
                    *(u32x4*)(P + off + bj * HALF) = pack8(p0 + ub4(g.x) * acc[ai][bj][m][0], p1 + ub4(g.y) * acc[ai][bj][m][1]); } }
    }
};
template <bool F32IN> struct EpiResid {
    static constexpr bool PERM = true, AFTER_DRAIN = false, HAS_MID = false;
    const float* xin; bf16_t* xb; float sc;
    __device__ __forceinline__ void operator()(const f32x4 (&acc)[2][2][4][2], const Unit& u, int wr, int wc, int fr, int fq) const {
        const int col0 = u.pn * BM + wc * 32 + 8 * fq, row0 = u.pm * BM + wr * 64 + fr;
#pragma unroll
        for (int ai = 0; ai < 2; ++ai) { f32x4 xv[4][2][2];
#pragma unroll
            for (int m = 0; m < 4; ++m)
#pragma unroll
                for (int bj = 0; bj < 2; ++bj) { const size_t o = (size_t)(row0 + ai * HALF + m * 16) * 1024 + col0 + bj * HALF;
                    if (F32IN) { xv[m][bj][0] = *(const f32x4*)(xin + o); xv[m][bj][1] = *(const f32x4*)(xin + o + 4); }
                    else { const u32x4 w0 = *(const u32x4*)(xb + o); xv[m][bj][0] = (f32x4){bf_lo(w0.x), bf_hi(w0.x), bf_lo(w0.y), bf_hi(w0.y)}; xv[m][bj][1] = (f32x4){bf_lo(w0.z), bf_hi(w0.z), bf_lo(w0.w), bf_hi(w0.w)}; } }
#pragma unroll
            for (int m = 0; m < 4; ++m)
#pragma unroll
                for (int bj = 0; bj < 2; ++bj) { const size_t o = (size_t)(row0 + ai * HALF + m * 16) * 1024 + col0 + bj * HALF;
                    *(u32x4*)(xb + o) = pack8(xv[m][bj][0] + acc[ai][bj][m][0] * sc, xv[m][bj][1] + acc[ai][bj][m][1] * sc); } }
    }
};
template <class RS, bool CS = false, bool F8OUT = false> struct EpiSwiGLU {
    static constexpr bool PERM = true, AFTER_DRAIN = false, HAS_MID = false;
    bf16_t* H; int ldh; RS rs; const float* cs; float f8scale;
    __device__ __forceinline__ void operator()(const f32x4 (&acc)[2][2][4][2], const Unit& u, int wr, int wc, int fr, int fq) const {
        const int col0 = u.pn * HALF + wc * 32 + 8 * fq, row0 = u.pm * BM + wr * 64 + fr;
        f32x4 cg[2], cu[2];
#pragma unroll
        for (int n = 0; n < 2; ++n) { if (CS) { cg[n] = *(const f32x4*)(cs + u.pn * BM + wc * 32 + 8 * fq + 4 * n); cu[n] = *(const f32x4*)(cs + u.pn * BM + HALF + wc * 32 + 8 * fq + 4 * n); }
                                      else { cg[n] = (f32x4){1.f, 1.f, 1.f, 1.f}; cu[n] = cg[n]; } }
        float s8[2][4];
#pragma unroll
        for (int ai = 0; ai < 2; ++ai)
#pragma unroll
            for (int m = 0; m < 4; ++m) s8[ai][m] = rs.get(row0 + ai * HALF + m * 16, fq);
#pragma unroll
        for (int ai = 0; ai < 2; ++ai)
#pragma unroll
            for (int m = 0; m < 4; ++m) { const int row = row0 + ai * HALF + m * 16; const float s = s8[ai][m]; f32x4 h[2];
#pragma unroll
                for (int n = 0; n < 2; ++n) { f32x4 g = acc[ai][0][m][n] * s, uu = acc[ai][1][m][n] * s; if (CS) { g = g * cg[n]; uu = uu * cu[n]; }
#pragma unroll
                    for (int i = 0; i < 4; ++i) h[n][i] = g[i] * uu[i] * sigmoidf_(g[i]); }
                if (F8OUT) { f32x4 q0 = h[0] * f8scale, q1 = h[1] * f8scale;
#pragma unroll
                    for (int i = 0; i < 4; ++i) { q0[i] = fminf(fmaxf(q0[i], -448.f), 448.f); q1[i] = fminf(fmaxf(q1[i], -448.f), 448.f); }
                    u32x2 w; w.x = pack4_fp8(q0[0], q0[1], q0[2], q0[3]); w.y = pack4_fp8(q1[0], q1[1], q1[2], q1[3]); *(u32x2*)((unsigned char*)H + (size_t)row * ldh + col0) = w; }
                else *(u32x4*)(H + (size_t)row * ldh + col0) = pack8(h[0], h[1]); }
    }
};
struct RowScaleP16X { const float* p; const float* xs;
    __device__ __forceinline__ float get(int row, int fq) const { return RowScaleP16{p}.get(row, fq) * xs[row]; } };
struct EpiPlainBf16 {
    static constexpr bool PERM = true, AFTER_DRAIN = false, HAS_MID = false;
    bf16_t* O; int ldc; float sc;
    __device__ __forceinline__ void operator()(const f32x4 (&acc)[2][2][4][2], const Unit& u, int wr, int wc, int fr, int fq) const {
        const int col0 = u.pn * BM + wc * 32 + 8 * fq, row0 = u.pm * BM + wr * 64 + fr;
#pragma unroll
        for (int ai = 0; ai < 2; ++ai)
#pragma unroll
            for (int m = 0; m < 4; ++m) { bf16_t* rowp = O + (size_t)(row0 + ai * HALF + m * 16) * ldc + col0;
#pragma unroll
                for (int bj = 0; bj < 2; ++bj) *(u32x4*)(rowp + bj * HALF) = pack8(acc[ai][bj][m][0] * sc, acc[ai][bj][m][1] * sc); }
    }
};

typedef int i32x4_t __attribute__((ext_vector_type(4)));
template <bool I8> __device__ __forceinline__ f32x4 mma16(const bf16x8 b, const bf16x8 a, const f32x4 c) {
    if constexpr (I8) return __builtin_bit_cast(f32x4, __builtin_amdgcn_mfma_i32_16x16x64_i8(__builtin_bit_cast(i32x4_t, b), __builtin_bit_cast(i32x4_t, a), __builtin_bit_cast(i32x4_t, c), 0, 0, 0));
    else return __builtin_amdgcn_mfma_f32_16x16x32_bf16(b, a, c, 0, 0, 0);
}
typedef int i32x8_t __attribute__((ext_vector_type(8)));
__device__ __forceinline__ f32x4 mma16_f8(const bf16x8 b0, const bf16x8 b1, const bf16x8 a0, const bf16x8 a1, const f32x4 c) {
    const i32x8_t vb = __builtin_shufflevector(__builtin_bit_cast(i32x4_t, b0), __builtin_bit_cast(i32x4_t, b1), 0, 1, 2, 3, 4, 5, 6, 7);
    const i32x8_t va = __builtin_shufflevector(__builtin_bit_cast(i32x4_t, a0), __builtin_bit_cast(i32x4_t, a1), 0, 1, 2, 3, 4, 5, 6, 7);
    return __builtin_amdgcn_mfma_scale_f32_16x16x128_f8f6f4(vb, va, c, 0, 0, 0, 0x7f7f7f7f, 0, 0x7f7f7f7f);
}
template <class Epi, class Sched, bool ALIGN_EPI = false, bool SP2 = false, bool I8 = false, bool F8 = false>
__device__ __forceinline__ void gemm_phase(PG8_LAS unsigned char* lds, const Gemm g, const Sched& S, const Epi& E, const int wid_in  ) {
    int lane_; asm volatile("v_mbcnt_lo_u32_b32 %0, -1, 0\n\tv_mbcnt_hi_u32_b32 %0, -1, %0" : "=v"(lane_));
    const int wid = wid_in, tid = wid * 64 + lane_, lane = lane_, wr = wid >> 2, wc = wid & 3, fr = lane & 15, fq = lane >> 4;
    const int K = g.K, nt = K / BK;
    unsigned voffA[2], voffB[2];
#pragma unroll
    for (int i = 0; i < 2; ++i) { int R, C; stage_rc(tid * 16 + i * 8192, R, C); const int Rb = Epi::PERM ? ((R & ~31) + perm32(R & 31)) : R;
        voffA[i] = (unsigned)(R * K + C) * 2u; voffB[i] = (unsigned)(Rb * K + C) * 2u; }
    const size_t kstep = (size_t)(BK * 2);
    const size_t hstep = (size_t)HALF * K * 2;
    const size_t tstep = 2 * hstep; const size_t rstep = (size_t)K * 2;
    const unsigned ldsw = (unsigned)wid * 1024u;
    const int aoff = lds_byte(wr * 64 + fr, fq * 8), boff = lds_byte(wc * 32 + fr, fq * 8);
#define PG8_SA(b, h) (((b) * 2 + (h)) * HTB)
#define PG8_SB(b, h) ((4 + (b) * 2 + (h)) * HTB)
#define PG8_STAGE(bufoff, gbase, voff) do { _Pragma("unroll") for (int _i = 0; _i < 2; ++_i) \
        __builtin_amdgcn_global_load_lds((const unsigned*)((const char*)(gbase) + (voff)[_i]), (PG8_LAS unsigned*)(lds + (bufoff) + ldsw + _i * 8192), 16, 0, 0); } while (0)
#define PG8_LDA(dst, b, h) do { if constexpr (F8) { _Pragma("unroll") for (int m = 0; m < 4; ++m) { const i32x4_t lo_ = *(const PG8_LAS i32x4_t*)(lds + PG8_SA(b, h) + aoff + m * 2048), hi_ = *(const PG8_LAS i32x4_t*)(lds + PG8_SA(b, h) + aoff + m * 2048 + 1024); \
        dst##8[m] = __builtin_shufflevector(lo_, hi_, 0, 1, 2, 3, 4, 5, 6, 7); } } else { _Pragma("unroll") for (int m = 0; m < 4; ++m) _Pragma("unroll") for (int k = 0; k < 2; ++k) dst[m][k] = *(const PG8_LAS bf16x8*)(lds + PG8_SA(b, h) + aoff + m * 2048 + k * 1024); } } while (0)
#define PG8_LDB(dst, b, h) do { if constexpr (F8) { _Pragma("unroll") for (int n = 0; n < 2; ++n) { const i32x4_t lo_ = *(const PG8_LAS i32x4_t*)(lds + PG8_SB(b, h) + boff + n * 2048), hi_ = *(const PG8_LAS i32x4_t*)(lds + PG8_SB(b, h) + boff + n * 2048 + 1024); \
        dst##8[n] = __builtin_shufflevector(lo_, hi_, 0, 1, 2, 3, 4, 5, 6, 7); } } else { _Pragma("unroll") for (int n = 0; n < 2; ++n) _Pragma("unroll") for (int k = 0; k < 2; ++k) dst[n][k] = *(const PG8_LAS bf16x8*)(lds + PG8_SB(b, h) + boff + n * 2048 + k * 1024); } } while (0)
#define PG8_MMA(ai, bj, At, Bt) do { __builtin_amdgcn_s_setprio(1); if constexpr (F8) { _Pragma("unroll") for (int m = 0; m < 4; ++m) _Pragma("unroll") for (int n = 0; n < 2; ++n) \
        asm volatile("v_mfma_scale_f32_16x16x128_f8f6f4 %0, %1, %2, %0, %3, %3 op_sel_hi:[0,0,0]" : "+v"(acc[ai][bj][m][n]) : "v"(Bt##8[n]), "v"(At##8[m]), "v"(f8one)); } else { _Pragma("unroll") for (int m = 0; m < 4; ++m) _Pragma("unroll") for (int n = 0; n < 2; ++n) _Pragma("unroll") for (int k = 0; k < 2; ++k) \
        acc[ai][bj][m][n] = mma16<I8>(Bt[n][k], At[m][k], acc[ai][bj][m][n]); } __builtin_amdgcn_s_setprio(0); } while (0)
#define PG8_WAIT_V(n) asm volatile("s_waitcnt vmcnt(" #n ")" ::: "memory")
#define PG8_WAIT_L(n) asm volatile("s_waitcnt lgkmcnt(" #n ")" ::: "memory")
#define PG8_BAR __builtin_amdgcn_s_barrier()
#define PG8_SCHED __builtin_amdgcn_sched_barrier(0)
    Unit cur, nxt; int ui = 0;
    if (!S.next(0, cur)) return;
    f32x4 acc[2][2][4][2];
#pragma unroll
    for (int a = 0; a < 2; ++a)
#pragma unroll
        for (int b = 0; b < 2; ++b)
#pragma unroll
            for (int m = 0; m < 4; ++m)
#pragma unroll
                for (int n = 0; n < 2; ++n) acc[a][b][m][n] = (f32x4){0.f, 0.f, 0.f, 0.f};
    const int f8one = 0x7f7f7f7f;
    bf16x8 At[4][2], B0[2][2], B1[2][2]; i32x8_t At8[4], B08[2], B18[2];
    const char* cA = (const char*)(cur.seg ? g.A2 : g.A) + (size_t)cur.pm * tstep; const char* cB = (const char*)(cur.seg ? g.Bt2 : g.Bt) + (size_t)cur.pn * tstep + (size_t)cur.be * rstep;
    S.a_ready(cur);
    if constexpr (SP2) {
        PG8_STAGE(PG8_SB(0, 0), cB, voffB); PG8_STAGE(PG8_SB(0, 1), cB + hstep, voffB); PG8_STAGE(PG8_SA(0, 0), cA, voffA); PG8_STAGE(PG8_SA(0, 1), cA + hstep, voffA);
        if (wr == 1) PG8_BAR;
        PG8_WAIT_V(2); PG8_BAR;
        PG8_STAGE(PG8_SB(1, 0), cB + kstep, voffB); PG8_STAGE(PG8_SA(1, 0), cA + kstep, voffA); PG8_STAGE(PG8_SB(1, 1), cB + hstep + kstep, voffB);
        PG8_WAIT_V(6); PG8_BAR;
    } else {
        PG8_STAGE(PG8_SB(0, 0), cB, voffB); PG8_STAGE(PG8_SA(0, 0), cA, voffA); PG8_STAGE(PG8_SB(0, 1), cB + hstep, voffB); PG8_STAGE(PG8_SA(0, 1), cA + hstep, voffA);
        if (wr == 1) PG8_BAR;
        PG8_WAIT_V(4); PG8_BAR;
        PG8_STAGE(PG8_SB(1, 0), cB + kstep, voffB); PG8_STAGE(PG8_SA(1, 0), cA + kstep, voffA); PG8_STAGE(PG8_SB(1, 1), cB + hstep + kstep, voffB);
        PG8_WAIT_V(6); PG8_BAR;
    }
    for (;;) {
        const bool has_next = S.next(ui + 1, nxt);
        const char* nA = has_next ? (const char*)(nxt.seg ? g.A2 : g.A) + (size_t)nxt.pm * tstep : cA; const char* nB = has_next ? (const char*)(nxt.seg ? g.Bt2 : g.Bt) + (size_t)nxt.pn * tstep + (size_t)nxt.be * rstep : cB;
        for (int t = 0; t < nt; t += 2) {
            const bool last = (t == nt - 2);
            const char* a1 = cA + (size_t)(t + 1) * kstep;
            const char* a2 = last ? nA : cA + (size_t)(t + 2) * kstep; const char* b2 = last ? nB : cB + (size_t)(t + 2) * kstep;
            const char* a3 = a2 + kstep; const char* b3 = b2 + kstep;
            if (last && has_next) S.a_ready(nxt);
            if constexpr (SP2) {
            PG8_LDB(B0, 0, 0); PG8_LDB(B1, 0, 1); PG8_SCHED; PG8_LDA(At, 0, 0); PG8_STAGE(PG8_SA(1, 1), a1 + hstep, voffA);
            PG8_WAIT_V(8); PG8_WAIT_L(0); PG8_BAR; PG8_MMA(0, 0, At, B0); PG8_MMA(0, 1, At, B1); PG8_BAR; PG8_SCHED;
            PG8_LDA(At, 0, 1); PG8_STAGE(PG8_SB(0, 0), b2, voffB); PG8_STAGE(PG8_SB(0, 1), b2 + hstep, voffB); PG8_STAGE(PG8_SA(0, 0), a2, voffA);
            PG8_WAIT_V(8); PG8_WAIT_L(0); PG8_BAR; PG8_MMA(1, 0, At, B0); PG8_MMA(1, 1, At, B1); PG8_BAR; PG8_SCHED;
            PG8_LDB(B0, 1, 0); PG8_LDB(B1, 1, 1); PG8_SCHED; PG8_LDA(At, 1, 0); PG8_STAGE(PG8_SA(0, 1), a2 + hstep, voffA);
            PG8_WAIT_V(8); PG8_WAIT_L(0); PG8_BAR; PG8_MMA(0, 0, At, B0); PG8_MMA(0, 1, At, B1); PG8_BAR; PG8_SCHED;
            PG8_LDA(At, 1, 1); PG8_STAGE(PG8_SB(1, 0), b3, voffB); PG8_STAGE(PG8_SB(1, 1), b3 + hstep, voffB); PG8_STAGE(PG8_SA(1, 0), a3, voffA);
            PG8_WAIT_V(8); PG8_WAIT_L(0); PG8_BAR; PG8_MMA(1, 0, At, B0); PG8_MMA(1, 1, At, B1); PG8_BAR; PG8_SCHED;
            } else {
            PG8_LDB(B0, 0, 0); PG8_SCHED; PG8_LDA(At, 0, 0); PG8_STAGE(PG8_SA(1, 1), a1 + hstep, voffA);
            PG8_WAIT_L(8); PG8_BAR; PG8_WAIT_L(0); PG8_MMA(0, 0, At, B0); PG8_BAR; PG8_SCHED;
            PG8_LDB(B1, 0, 1); PG8_STAGE(PG8_SB(0, 0), b2, voffB);
            PG8_BAR; PG8_WAIT_L(0); PG8_MMA(0, 1, At, B1); PG8_BAR;
            PG8_LDA(At, 0, 1); PG8_STAGE(PG8_SA(0, 0), a2, voffA);
            PG8_BAR; PG8_WAIT_L(0); PG8_MMA(1, 0, At, B0); PG8_BAR; PG8_SCHED;
            PG8_STAGE(PG8_SB(0, 1), b2 + hstep, voffB);
            PG8_WAIT_V(6); PG8_BAR; PG8_MMA(1, 1, At, B1); PG8_BAR;
            PG8_LDB(B0, 1, 0); PG8_SCHED; PG8_LDA(At, 1, 0); PG8_STAGE(PG8_SA(0, 1), a2 + hstep, voffA);
            PG8_WAIT_L(8); PG8_BAR; PG8_WAIT_L(0); PG8_MMA(0, 0, At, B0); PG8_BAR; PG8_SCHED;
            PG8_LDB(B1, 1, 1); PG8_STAGE(PG8_SB(1, 0), b3, voffB);
            PG8_BAR; PG8_WAIT_L(0); PG8_MMA(0, 1, At, B1); PG8_BAR;
            PG8_LDA(At, 1, 1); PG8_STAGE(PG8_SA(1, 0), a3, voffA);
            PG8_BAR; PG8_WAIT_L(0); PG8_MMA(1, 0, At, B0); PG8_BAR; PG8_SCHED;
            PG8_STAGE(PG8_SB(1, 1), b3 + hstep, voffB);
            PG8_WAIT_V(6); PG8_BAR; PG8_MMA(1, 1, At, B1); PG8_BAR;
            }
        }
        if constexpr (ALIGN_EPI) { if (wr == 0) PG8_BAR; }
        if constexpr (F8) asm volatile("s_nop 15\n\ts_nop 15" ::: "memory");
        if constexpr (I8) {
#pragma unroll
            for (int a = 0; a < 2; ++a)
#pragma unroll
                for (int b = 0; b < 2; ++b)
#pragma unroll
                    for (int m = 0; m < 4; ++m)
#pragma unroll
                        for (int n = 0; n < 2; ++n) { const i32x4_t iv = __builtin_bit_cast(i32x4_t, acc[a][b][m][n]); acc[a][b][m][n] = (f32x4){(float)iv[0], (float)iv[1], (float)iv[2], (float)iv[3]}; } }
        bool carry = false;
        if constexpr (Epi::HAS_MID) { if (cur.seg == 0) { E.mid(acc, cur, wr, wc, fr, fq); carry = true; } }
        if constexpr (!Epi::AFTER_DRAIN) { if (!carry) { E(acc, cur, wr, wc, fr, fq); S.done(cur); } }
        if (!has_next) break;
        if (!carry)
#pragma unroll
        for (int a = 0; a < 2; ++a)
#pragma unroll
            for (int b = 0; b < 2; ++b)
#pragma unroll
                for (int m = 0; m < 4; ++m)
#pragma unroll
                    for (int n = 0; n < 2; ++n) acc[a][b][m][n] = (f32x4){0.f, 0.f, 0.f, 0.f};
        cur = nxt; cA = nA; cB = nB; ++ui;
        if constexpr (ALIGN_EPI) { if (wr == 1) PG8_BAR; }
    }
    PG8_WAIT_V(0);
    if constexpr (!ALIGN_EPI) { if (wr == 0) PG8_BAR; }
    PG8_BAR;
    if constexpr (Epi::AFTER_DRAIN) { E.fused(acc, cur, wr, wc, fr, fq, lds, wid, lane); S.done(cur); }
#undef PG8_SA
#undef PG8_SB
#undef PG8_STAGE
#undef PG8_LDA
#undef PG8_LDB
#undef PG8_MMA
#undef PG8_WAIT_V
#undef PG8_WAIT_L
#undef PG8_BAR
#undef PG8_SCHED
}
}

namespace dattn {
using bf16 = unsigned short;
using bf16x8 = __attribute__((ext_vector_type(8))) short;
using s16x4 = __attribute__((ext_vector_type(4))) short;
using f32x16 = __attribute__((ext_vector_type(16))) float;
using f32x4 = __attribute__((ext_vector_type(4))) float;
using u32x4 = __attribute__((ext_vector_type(4))) unsigned;
constexpr int SEQ = 16384, PITCH = 1024, KVBLK = 64, QBLK = 32, UROWS = 128;
constexpr int SHM_V = KVBLK * 128 * 2, SHM_K = KVBLK * 128 * 2;
constexpr int XPITCH = 132;
constexpr int L_V = 0, L_K = 2 * SHM_V, L_XCH = 0, XCH_WAVE = 32 * XPITCH * 4, L_WS = 4 * XCH_WAVE, L_TAB = L_WS + 8 * 256, LDS_BYTES = L_TAB + 384 * 4;
static_assert(L_WS >= 2 * SHM_V + 2 * SHM_K, "exchange region overlays the K/V buffers");
constexpr float LOG2E = 1.4426950408889634f;
constexpr float THR = 8.f;
__constant__ unsigned char BKT[128] = {0, 1, 2, 3, 4, 5, 6, 7, 8, 9, 10, 11, 12, 13, 14, 15, 16, 16, 16, 17, 17, 18, 18, 18, 19, 19, 19, 20, 20, 20, 20, 21, 21, 21, 21, 22, 22, 22, 22, 22, 23, 23, 23, 23, 23, 23, 24, 24, 24, 24, 24, 24,
    25, 25, 25, 25, 25, 25, 25, 26, 26, 26, 26, 26, 26, 26, 26, 27, 27, 27, 27, 27, 27, 27, 27, 27, 27, 28, 28, 28, 28, 28, 28, 28, 28, 28, 28, 29, 29, 29, 29, 29, 29, 29, 29, 29, 29, 29, 29,
    30, 30, 30, 30, 30, 30, 30, 30, 30, 30, 30, 30, 30, 30, 31, 31, 31, 31, 31, 31, 31, 31, 31, 31, 31, 31, 31, 31, 31};
#define KSWZ(row, colB) ((row) * 256 + ((colB) ^ (((row) & 7) << 4)))
#define SBAR() __builtin_amdgcn_sched_barrier(0)
__device__ __forceinline__ int crow(int r, int hi) { return (r & 3) + 8 * (r >> 2) + 4 * hi; }
__device__ __forceinline__ unsigned cvtpk(float lo, float hi) { unsigned r; asm volatile("v_cvt_pk_bf16_f32 %0, %1, %2" : "=v"(r) : "v"(lo), "v"(hi)); return r; }

__device__ __forceinline__ void softmaxY(f32x16& p0, f32x16& p1, float& m_reg, float& l_reg, f32x16& negm, f32x16* o, float* al_l, int r32, int hi, bool band, bool first, const float* tl,
                                         bf16x8& pa0, bf16x8& pa1, bf16x8& pa2, bf16x8& pa3) {
  if (band) {
#pragma unroll
    for (int r = 0; r < 16; ++r) { const int c = (r & 3) + 8 * (r >> 2); p0[r] += tl[c]; p1[r] += tl[32 + c]; }
  }
  float pa = fmaxf(fmaxf(p0[0], p0[1]), p1[0]), pb = fmaxf(fmaxf(p0[2], p0[3]), p1[1]); pa = fmaxf(fmaxf(pa, p1[2]), p1[3]);
#pragma unroll
  for (int r = 4; r < 16; r += 4) { pa = fmaxf(fmaxf(pa, p0[r]), p0[r + 1]); pb = fmaxf(fmaxf(pb, p0[r + 2]), p0[r + 3]); pa = fmaxf(fmaxf(pa, p1[r]), p1[r + 1]); pb = fmaxf(fmaxf(pb, p1[r + 2]), p1[r + 3]); }
  float pmax = fmaxf(pa, pb);
  { auto rr = __builtin_amdgcn_permlane32_swap(__float_as_uint(pmax), __float_as_uint(pmax), false, false);
    pmax = fmaxf(__uint_as_float(rr[0]), __uint_as_float(rr[1])); }
  if (__builtin_expect(first || !__all(pmax <= THR), 0)) {
    const float dl = first ? pmax : fmaxf(pmax, 0.f), alpha = __builtin_amdgcn_exp2f(-dl); m_reg += dl; l_reg *= alpha;
#pragma unroll
    for (int r = 0; r < 16; ++r) { p0[r] -= dl; p1[r] -= dl; negm[r] = -m_reg; }
    if (hi == 0) al_l[r32] = alpha;
    asm volatile("s_waitcnt lgkmcnt(0)" ::: "memory");
#pragma unroll
    for (int d = 0; d < 4; ++d)
#pragma unroll
      for (int r = 0; r < 16; ++r) o[d][r] *= al_l[crow(r, hi)];
  }
#pragma unroll
  for (int r = 0; r < 16; ++r) { p0[r] = __builtin_amdgcn_exp2f(p0[r]); p1[r] = __builtin_amdgcn_exp2f(p1[r]); }
  float ps = 0.f, ps2 = 0.f;
#pragma unroll
  for (int r = 0; r < 16; ++r) { ps += p0[r]; ps2 += p1[r]; }
  ps += ps2;
  { auto rr = __builtin_amdgcn_permlane32_swap(__float_as_uint(ps), __float_as_uint(ps), false, false);
    ps = __uint_as_float(rr[0]) + __uint_as_float(rr[1]); }
  l_reg += ps;
#define PK4(P, BASE, OUT) do { u32x4 w = {cvtpk(P[BASE + 0], P[BASE + 1]), cvtpk(P[BASE + 2], P[BASE + 3]), cvtpk(P[BASE + 4], P[BASE + 5]), cvtpk(P[BASE + 6], P[BASE + 7])}; \
    OUT = *reinterpret_cast<bf16x8*>(&w); } while (0)
  PK4(p0, 0, pa0); PK4(p0, 8, pa1); PK4(p1, 0, pa2); PK4(p1, 8, pa3);
#undef PK4
}
__device__ __forceinline__ void qkt(f32x16& p0, f32x16& p1, const char* Ks, const bf16x8* qr, int r32, int hi, int map) {
  p0 = f32x16{}; p1 = f32x16{};
#pragma unroll
  for (int d0 = 0; d0 < 4; ++d0) { const int cb = (map * 64 + d0 * 16 + hi * 8) * 2;
    const bf16x8 b0 = *reinterpret_cast<const bf16x8*>(Ks + KSWZ(r32, cb));
    const bf16x8 b1 = *reinterpret_cast<const bf16x8*>(Ks + KSWZ(32 + r32, cb));
    p0 = __builtin_amdgcn_mfma_f32_32x32x16_bf16(b0, qr[d0], p0, 0, 0, 0);
    p1 = __builtin_amdgcn_mfma_f32_32x32x16_bf16(b1, qr[d0], p1, 0, 0, 0); }
}
__device__ __forceinline__ int v_st(int k, int c) { const int kk = (k & ~0xC) | ((k & 4) << 1) | ((k & 8) >> 1); return ((kk >> 3) * 4 + (c >> 5)) * 512 + ((kk & 7) * 32 + (c & 31)) * 2; }
__device__ __forceinline__ int v_rd_base(int lane) { return ((lane & 3) << 3) | (((lane >> 2) & 3) << 6) | (((lane >> 4) & 1) << 5) | (((lane >> 5) & 1) << 8); }
constexpr int v_rd_off(int d0, int ks, int half) { return d0 * 512 + ks * 4096 + half * 2048; }
typedef short v4i16_t __attribute__((ext_vector_type(4)));
template <int OFF> __device__ __forceinline__ s16x4 tr_read(int vb) {
  return __builtin_bit_cast(s16x4, __builtin_amdgcn_ds_read_tr16_b64_v4i16((__attribute__((address_space(3))) v4i16_t*)(size_t)(unsigned)(vb + OFF)));
}
template <int D0> __device__ __forceinline__ void pv_one(f32x16& od, int vb, bf16x8 pa0, bf16x8 pa1, bf16x8 pa2, bf16x8 pa3) {
  const s16x4 l0 = tr_read<v_rd_off(D0, 0, 0)>(vb), h0 = tr_read<v_rd_off(D0, 0, 1)>(vb), l1 = tr_read<v_rd_off(D0, 1, 0)>(vb), h1 = tr_read<v_rd_off(D0, 1, 1)>(vb);
  const s16x4 l2 = tr_read<v_rd_off(D0, 2, 0)>(vb), h2 = tr_read<v_rd_off(D0, 2, 1)>(vb), l3 = tr_read<v_rd_off(D0, 3, 0)>(vb), h3 = tr_read<v_rd_off(D0, 3, 1)>(vb);
#define PK(L, H) (bf16x8){L[0], L[1], L[2], L[3], H[0], H[1], H[2], H[3]}
  od = __builtin_amdgcn_mfma_f32_32x32x16_bf16(pa0, PK(l0, h0), od, 0, 0, 0);
  od = __builtin_amdgcn_mfma_f32_32x32x16_bf16(pa1, PK(l1, h1), od, 0, 0, 0);
  od = __builtin_amdgcn_mfma_f32_32x32x16_bf16(pa2, PK(l2, h2), od, 0, 0, 0);
  od = __builtin_amdgcn_mfma_f32_32x32x16_bf16(pa3, PK(l3, h3), od, 0, 0, 0);
#undef PK
}
__device__ __forceinline__ void pv_d0(f32x16* o, int vb, bf16x8 pa0, bf16x8 pa1, bf16x8 pa2, bf16x8 pa3) {
  pv_one<0>(o[0], vb, pa0, pa1, pa2, pa3); pv_one<1>(o[1], vb, pa0, pa1, pa2, pa3); pv_one<2>(o[2], vb, pa0, pa1, pa2, pa3); pv_one<3>(o[3], vb, pa0, pa1, pa2, pa3);
}

template <bool QK, bool PV>
__device__ __forceinline__ void xphase(f32x16& s0, f32x16& s1, const f32x16& negm, f32x16* o, const char* Ks, int vb, const bf16x8* qr, bf16x8 pa0, bf16x8 pa1, bf16x8 pa2, bf16x8 pa3, int r32, int hi, int map) {
  constexpr int N0 = QK ? 0 : 8, N1 = PV ? 24 : 8, AHEAD = 2;
  bf16x8 f[4];
#define XLD(n) do { if ((n) < 8) { const int d0_ = (n) >> 1, hf_ = (n) & 1; \
      f[(n) & 3] = *reinterpret_cast<const bf16x8*>(Ks + KSWZ(hf_ * 32 + r32, (map * 64 + d0_ * 16 + hi * 8) * 2)); } \
    else { const int m_ = (n) - 8, D0_ = m_ >> 2, ks_ = m_ & 3; \
      const s16x4 lo_ = __builtin_bit_cast(s16x4, __builtin_amdgcn_ds_read_tr16_b64_v4i16((__attribute__((address_space(3))) v4i16_t*)(size_t)(unsigned)(vb + D0_ * 512 + ks_ * 4096))); \
      const s16x4 hi2_ = __builtin_bit_cast(s16x4, __builtin_amdgcn_ds_read_tr16_b64_v4i16((__attribute__((address_space(3))) v4i16_t*)(size_t)(unsigned)(vb + D0_ * 512 + ks_ * 4096 + 2048))); \
      f[(n) & 3] = (bf16x8){lo_[0], lo_[1], lo_[2], lo_[3], hi2_[0], hi2_[1], hi2_[2], hi2_[3]}; } } while (0)
#pragma unroll
  for (int n = N0; n < N0 + AHEAD; ++n) XLD(n);
#pragma unroll
  for (int n = N0; n < N1; ++n) {
    if (n + AHEAD < N1) XLD(n + AHEAD);
    SBAR();
    if (n < 8) { if (n & 1) s1 = __builtin_amdgcn_mfma_f32_32x32x16_bf16(f[n & 3], qr[n >> 1], n == 1 ? negm : s1, 0, 0, 0); else s0 = __builtin_amdgcn_mfma_f32_32x32x16_bf16(f[n & 3], qr[n >> 1], n == 0 ? negm : s0, 0, 0, 0); }
    else { const int m_ = n - 8, D0_ = m_ >> 2, ks_ = m_ & 3; const bf16x8 pa_ = ks_ == 0 ? pa0 : ks_ == 1 ? pa1 : ks_ == 2 ? pa2 : pa3;
      o[D0_] = __builtin_amdgcn_mfma_f32_32x32x16_bf16(pa_, f[n & 3], o[D0_], 0, 0, 0); }
    SBAR();
  }
#undef XLD
}
__device__ __forceinline__ void glds16s(unsigned voff, const void* sbase, unsigned lds_dst) {
  unsigned keep;
  asm volatile("s_mov_b32 %0, m0\n\ts_mov_b32 m0, %3\n\ts_nop 0\n\tglobal_load_lds_dwordx4 %1, %2\n\ts_mov_b32 m0, %0" : "=&s"(keep) : "v"(voff), "s"(sbase), "s"(lds_dst) : "memory");
}
#define BAR_L()  asm volatile("s_waitcnt lgkmcnt(0)\n\ts_barrier" ::: "memory")
#define BAR_VL() asm volatile("s_waitcnt vmcnt(0) lgkmcnt(0)\n\ts_barrier" ::: "memory")
__device__ __forceinline__ void attn_unit(int b, int h, int qb, const bf16* Zq, const bf16* __restrict__ Zk, const bf16* __restrict__ Zv, bf16* Oa,
                                          const float* __restrict__ rel_bias, const float* par, int layer, const float* __restrict__ gsub, char* lds, const int wid_in) {
  int lane_; asm volatile("v_mbcnt_lo_u32_b32 %0, -1, 0\n\tv_mbcnt_hi_u32_b32 %0, -1, %0" : "=v"(lane_));
  const int wid = wid_in, lane = lane_, tid = wid * 64 + lane, r32 = lane & 31, hi = lane >> 5;
  const int map = wid >> 2, g = wid & 3; const bool grpB = (wid >= 4);
  const long rowbase = (long)b * SEQ; const int q0 = qb * UROWS, NT = 2 * qb + 2;
  char* V_lds = lds + L_V; char* K_lds = lds + L_K;
  float* tab = (float*)(lds + L_TAB);
  BAR_L();
  for (int i = tid; i < 384; i += 512) { const int dist = 255 - i; float v;
    if (dist < 0) v = -INFINITY; else if (dist >= 113) v = 0.f; else v = (rel_bias[(int)BKT[dist] * 8 + h] - rel_bias[31 * 8 + h]) * LOG2E;
    tab[i] = v; }
  const bf16* Kh = Zk + rowbase * PITCH + h * 128; const bf16* Vh = Zv + rowbase * PITCH + h * 128;
  unsigned kof0, kof1, vof0, vof1;
  { const int row0 = 8 * wid + (lane >> 4), row1 = row0 + 4, c0 = (lane & 15) ^ (row0 & 7), c1 = (lane & 15) ^ (row1 & 7);
    kof0 = (unsigned)(row0 * PITCH + c0 * 8) * 2u; kof1 = (unsigned)(row1 * PITCH + c1 * 8) * 2u;
    const int sub0 = 4 * wid + (lane >> 5), sub1 = sub0 + 2, klo = (lane & 31) >> 2, cin = 8 * (lane & 3);
    const int kk0 = (sub0 >> 2) * 8 + klo, kk1 = (sub1 >> 2) * 8 + klo;
    const int k0 = kk0, k1 = kk1;
    vof0 = (unsigned)(k0 * PITCH + (sub0 & 3) * 32 + cin) * 2u; vof1 = (unsigned)(k1 * PITCH + (sub1 & 3) * 32 + cin) * 2u; }
  const unsigned lds0 = (unsigned)(uintptr_t)lds;
  const unsigned kdst = (unsigned)__builtin_amdgcn_readfirstlane((int)(lds0 + L_K + 2 * wid * 1024)), vdst = (unsigned)__builtin_amdgcn_readfirstlane((int)(lds0 + L_V + 2 * wid * 1024));
#define DMA_K(t, sl) do { const bf16* kb_ = Kh + (long)(t) * KVBLK * PITCH; glds16s(kof0, kb_, kdst + (unsigned)(sl) * SHM_K); glds16s(kof1, kb_, kdst + (unsigned)(sl) * SHM_K + 1024u); } while (0)
#define DMA_V(t, sl) do { const bf16* vb_ = Vh + (long)(t) * KVBLK * PITCH; glds16s(vof0, vb_, vdst + (unsigned)(sl) * SHM_V); glds16s(vof1, vb_, vdst + (unsigned)(sl) * SHM_V + 1024u); } while (0)
#define ISSUE2(j) do { const int j_ = (j); if (j_ + 2 < NT) DMA_K(j_ + 2, j_ & 1); if (j_ + 1 < NT) DMA_V(j_ + 1, (j_ + 1) & 1); } while (0)
  DMA_K(0, 0); DMA_K(1, 1); DMA_V(0, 0);
  float m_reg = 0.f, l_reg = 0.f; f32x16 o[4] = {}; f32x16 negm = {}; bf16x8 qr[4];
  const bf16* Qw = Zq + (rowbase + q0 + g * QBLK + r32) * PITCH + h * 128 + map * 64 + hi * 8;
#pragma unroll
  for (int d0 = 0; d0 < 4; ++d0) qr[d0] = *reinterpret_cast<const bf16x8*>(Qw + d0 * 16);
  const int vb0 = (int)(uintptr_t)V_lds + v_rd_base(lane);
  const int qpos = q0 + g * QBLK + r32;
  const float* tl0 = tab + (255 - qpos + 4 * hi);
#define BAND(j) ((j) >= NT - 4)
#define AL_L() ((float*)(lds + L_WS) + wid * 64 + 32)
  f32x16 pS0, pS1; bf16x8 pa0 = {}, pa1 = {}, pa2 = {}, pa3 = {};
  BAR_VL();
  xphase<true, false>(pS0, pS1, negm, o, K_lds, vb0, qr, pa0, pa1, pa2, pa3, r32, hi, map);
  BAR_L();
  if (grpB) BAR_L();
#pragma unroll 1
  for (int i = 0; i < NT - 1; ++i) {
    if (grpB) ISSUE2(i);
    softmaxY(pS0, pS1, m_reg, l_reg, negm, o, AL_L(), r32, hi, BAND(i), i == 0, tl0 + i * KVBLK, pa0, pa1, pa2, pa3);
    if (grpB) BAR_L(); else BAR_VL();
    if (!grpB) ISSUE2(i);
    xphase<true, true>(pS0, pS1, negm, o, K_lds + ((i + 1) & 1) * SHM_K, vb0 + (i & 1) * SHM_V, qr, pa0, pa1, pa2, pa3, r32, hi, map);
    if (grpB) BAR_VL(); else BAR_L();
  }
  if (grpB) ISSUE2(NT - 1);
  softmaxY(pS0, pS1, m_reg, l_reg, negm, o, AL_L(), r32, hi, true, false, tl0 + (NT - 1) * KVBLK, pa0, pa1, pa2, pa3);
  if (grpB) BAR_L(); else BAR_VL();
  xphase<false, true>(pS0, pS1, negm, o, K_lds, vb0 + SHM_V, qr, pa0, pa1, pa2, pa3, r32, hi, map);
  if (!grpB) BAR_L();
  float* li_l = (float*)(lds + L_WS) + wid * 64;
  float lam, gmul; { const __attribute__((address_space(1))) float* pp = (const __attribute__((address_space(1))) float*)par; int l2 = layer; asm volatile("" : "+s"(pp), "+s"(l2)); lam = pp[l2]; gmul = 1.f - ((l2 == 0) ? 0.2f : (0.8f - 0.6f * 0.7408182206817179f)); }
  if (hi == 0) li_l[r32] = l_reg; asm volatile("s_waitcnt lgkmcnt(0)" ::: "memory");
  float rli[16];
#pragma unroll
  for (int r = 0; r < 16; ++r) rli[r] = __builtin_amdgcn_rcpf(li_l[crow(r, hi)]);
  float* X = (float*)(lds + L_XCH + g * XCH_WAVE);
  BAR_L();
  if (map == 1) {
#pragma unroll
    for (int d0 = 0; d0 < 4; ++d0)
#pragma unroll
      for (int r = 0; r < 16; ++r) X[crow(r, hi) * XPITCH + d0 * 32 + r32] = o[d0][r] * rli[r];
  }
  BAR_L();
  if (map == 0) {
#pragma unroll
    for (int d0 = 0; d0 < 4; ++d0)
#pragma unroll
      for (int r = 0; r < 16; ++r) { float* xp = &X[crow(r, hi) * XPITCH + d0 * 32 + r32]; *xp = o[d0][r] * rli[r] - lam * (*xp); }
    asm volatile("s_waitcnt lgkmcnt(0)" ::: "memory");
    const f32x4* xr = (const f32x4*)(X + r32 * XPITCH + hi * 64);
    f32x4 v[16]; float ss = 0.f;
#pragma unroll
    for (int i = 0; i < 16; ++i) { v[i] = xr[i]; ss += (v[i][0] * v[i][0] + v[i][1] * v[i][1]) + (v[i][2] * v[i][2] + v[i][3] * v[i][3]); }
    { auto rr = __builtin_amdgcn_permlane32_swap(__float_as_uint(ss), __float_as_uint(ss), false, false); ss = __uint_as_float(rr[0]) + __uint_as_float(rr[1]); }
    const float rs = __builtin_amdgcn_rsqf(ss * (1.0f / 128.0f) + 1e-6f) * gmul;
    bf16* op = Oa + (rowbase + q0 + g * QBLK + r32) * PITCH + h * 128 + hi * 64;
    const f32x4* gp = (const f32x4*)(gsub + hi * 64);
#pragma unroll
    for (int i = 0; i < 16; i += 2) { const f32x4 g0 = gp[i], g1 = gp[i + 1]; u32x4 w;
      w.x = cvtpk(v[i][0] * rs * g0[0], v[i][1] * rs * g0[1]); w.y = cvtpk(v[i][2] * rs * g0[2], v[i][3] * rs * g0[3]);
      w.z = cvtpk(v[i + 1][0] * rs * g1[0], v[i + 1][1] * rs * g1[1]); w.w = cvtpk(v[i + 1][2] * rs * g1[2], v[i + 1][3] * rs * g1[3]);
      *(u32x4*)(op + i * 4) = w; }
  }
#undef ISSUE2
#undef DMA_K
#undef DMA_V
#undef AL_L
#undef BAND
}

constexpr int L3_K = 0, L3_V = 3 * SHM_K, L3_WS = 3 * SHM_K + 3 * SHM_V, L3_TAB = L3_WS + 8 * 256, L3_FLG = L3_TAB + 384 * 4, LDS3_BYTES = L3_FLG + 32;
constexpr float FAST_B = 96.f;
static_assert(L3_WS >= 4 * XCH_WAVE, "exchange region overlays the K/V rings");
#define PIN(x) asm volatile("" : "+v"(x))
#define MFMA32(a, b, c) __builtin_amdgcn_mfma_f32_32x32x16_bf16(a, b, c, 0, 0, 0)
#define MX3(a, b, c) __builtin_fmaxf(__builtin_fmaxf((a), (b)), (c))
#define EX2(v) __builtin_amdgcn_exp2f(v)
__device__ __forceinline__ void attn_qload(bf16x8 (&q)[4], int b, int h, int qb, const bf16* Zq, int wid) {
  int lane_; asm volatile("v_mbcnt_lo_u32_b32 %0, -1, 0\n\tv_mbcnt_hi_u32_b32 %0, -1, %0" : "=v"(lane_));
  const int r32 = lane_ & 31, hi = lane_ >> 5, map = wid >> 2, g = wid & 3;
  const bf16* Qw = Zq + ((long)b * SEQ + qb * UROWS + g * QBLK + r32) * PITCH + h * 128 + map * 64 + hi * 8;
#pragma unroll
  for (int d0 = 0; d0 < 4; ++d0) q[d0] = *reinterpret_cast<const bf16x8*>(Qw + d0 * 16);
}
__device__ __forceinline__ void attn_unit3(int b, int h, int qb, bf16x8 (&qn)[4], int nb, int nh, int nqb, const bf16* Zq, const bf16* __restrict__ Zk, const bf16* __restrict__ Zv, bf16* Oa,
                                           const float* __restrict__ rel_bias, const float* par, int layer, const float* __restrict__ gsub, char* lds, const int wid_in, const unsigned* kmaxw) {
  int lane_; asm volatile("v_mbcnt_lo_u32_b32 %0, -1, 0\n\tv_mbcnt_hi_u32_b32 %0, -1, %0" : "=v"(lane_));
  const int wid = wid_in, lane = lane_, tid = wid * 64 + lane, r32 = lane & 31, hi = lane >> 5;
  const int map = wid >> 2, g = wid & 3;
  const long rowbase = (long)b * SEQ; const int q0 = qb * UROWS, NT = 2 * qb + 2;
  char* K_lds = lds + L3_K; char* V_lds = lds + L3_V;
  float* tab = (float*)(lds + L3_TAB);
  BAR_L();
  for (int i = tid; i < 384; i += 512) { const int dist = 255 - i; float v;
    if (dist < 0) v = -INFINITY; else if (dist >= 113) v = 0.f; else v = (rel_bias[(int)BKT[dist] * 8 + h] - rel_bias[31 * 8 + h]) * LOG2E;
    tab[i] = v; }
  const bf16* Kh = Zk + rowbase * PITCH + h * 128; const bf16* Vh = Zv + (size_t)((b * 8 + h) * 128) * SEQ;
  unsigned kof0, kof1, vof0, vof1;
  { const int row0 = 8 * wid + (lane >> 4), row1 = row0 + 4, c0 = (lane & 15) ^ (row0 & 7), c1 = (lane & 15) ^ (row1 & 7);
    kof0 = (unsigned)(row0 * PITCH + c0 * 8) * 2u; kof1 = (unsigned)(row1 * PITCH + c1 * 8) * 2u;
    const int dd0 = 16 * wid + (lane >> 3), dd1 = dd0 + 8, cc0 = (lane & 7) ^ ((dd0 >> 1) & 7), cc1 = (lane & 7) ^ ((dd1 >> 1) & 7);
    vof0 = (unsigned)(dd0 * SEQ * 2 + cc0 * 16); vof1 = (unsigned)(dd1 * SEQ * 2 + cc1 * 16); }
  const unsigned lds0 = (unsigned)(uintptr_t)lds;
  const unsigned kdst = (unsigned)__builtin_amdgcn_readfirstlane((int)(lds0 + L3_K + 2 * wid * 1024)), vdst = (unsigned)__builtin_amdgcn_readfirstlane((int)(lds0 + L3_V + 2 * wid * 1024));
#define DMA_K(t, sl) do { const bf16* kb_ = Kh + (long)(t) * KVBLK * PITCH; glds16s(kof0, kb_, kdst + (unsigned)(sl) * SHM_K); glds16s(kof1, kb_, kdst + (unsigned)(sl) * SHM_K + 1024u); } while (0)
#define DMA_V(t, sl) do { const bf16* vb_ = Vh + (long)(t) * KVBLK; glds16s(vof0, vb_, vdst + (unsigned)(sl) * SHM_V); glds16s(vof1, vb_, vdst + (unsigned)(sl) * SHM_V + 1024u); } while (0)
  DMA_K(0, 0); DMA_K(1, 1); DMA_V(0, 0);
  float m_reg = 0.f, l_reg = 0.f; f32x16 o[4] = {}; f32x16 negm = {}; bf16x8 qr[4];
#pragma unroll
  for (int d0 = 0; d0 < 4; ++d0) qr[d0] = qn[d0];
  { float qs = 0.f;
#pragma unroll
    for (int d0 = 0; d0 < 4; ++d0)
#pragma unroll
      for (int e = 0; e < 8; ++e) qs += __builtin_fabsf(__uint_as_float((unsigned)(unsigned short)qr[d0][e] << 16));
    { auto rr = __builtin_amdgcn_permlane32_swap(__float_as_uint(qs), __float_as_uint(qs), false, false); qs = __uint_as_float(rr[0]) + __uint_as_float(rr[1]); }
    const float kmx = __uint_as_float(((const __attribute__((address_space(1))) unsigned*)kmaxw)[h * 2 + map]) * 1.01f;
    float bm = __builtin_fabsf((rel_bias[(lane & 31) * 8 + h] - rel_bias[31 * 8 + h]) * LOG2E);
#pragma unroll
    for (int sft = 16; sft >= 1; sft >>= 1) bm = __builtin_fmaxf(bm, __shfl_xor(bm, sft));
    const int okw = __all(qs * kmx + bm <= FAST_B) ? 1 : 0;
    if (lane == 0) ((int*)(lds + L3_FLG))[wid] = okw; }
  int kfa[4];
#pragma unroll
  for (int d0 = 0; d0 < 4; ++d0) kfa[d0] = (int)(uintptr_t)K_lds + KSWZ(r32, (map * 64 + d0 * 16 + hi * 8) * 2);
  int vfb[4];
#pragma unroll
  for (int ks = 0; ks < 4; ++ks) vfb[ks] = (int)(uintptr_t)V_lds + r32 * 128 + (((2 * ks + hi) ^ ((r32 >> 1) & 7)) << 4);
  const int qpos = q0 + g * QBLK + r32;
  const float* tl0 = tab + (255 - qpos + 4 * hi);
  float* al_l = (float*)(lds + L3_WS) + wid * 64 + 32;
  typedef __attribute__((address_space(3))) const bf16x8* lds_frag_p;
#define KFRAG(n, ks_) (*(lds_frag_p)(size_t)(unsigned)(kfa[(n) >> 1] + ((n) & 1) * 8192 + (ks_)))
#define VFRAG(dst, m, vs_) do { dst = *(lds_frag_p)(size_t)(unsigned)(vfb[(m) & 3] + (vs_) + ((m) >> 2) * 4096); } while (0)
  f32x16 pA0, pA1, pB0, pB1; u32x4 pw0 = {}, pw1 = {}, pw2 = {}, pw3 = {}; bf16x8 f[4]; bool resc = false;
#define PWF(k) __builtin_bit_cast(bf16x8, pw##k)
#define BANDADD(C0, C1, T) do { const float* tl_ = tl0 + (T) * KVBLK; _Pragma("unroll") for (int r = 0; r < 16; ++r) { const int c_ = (r & 3) + 8 * (r >> 2); C0[r] += tl_[c_]; C1[r] += tl_[32 + c_]; } } while (0)
#define MOVEREF(C0, C1, DL) do { const float dl_ = (DL); m_reg += dl_; const float al_ = EX2(-dl_); l_reg *= al_; \
    _Pragma("unroll") for (int r = 0; r < 16; ++r) { C0[r] -= dl_; C1[r] -= dl_; negm[r] = -m_reg; } if (hi == 0) al_l[r32] = al_; resc = true; } while (0)
#define RESC() do { if (resc) { asm volatile("s_waitcnt lgkmcnt(0)" ::: "memory"); _Pragma("unroll") for (int d_ = 0; d_ < 4; ++d_) _Pragma("unroll") for (int r = 0; r < 16; ++r) o[d_][r] *= al_l[crow(r, hi)]; resc = false; } } while (0)
  BAR_VL();
  bool fast; { const u32x4 f0_ = ((const u32x4*)(lds + L3_FLG))[0], f1_ = ((const u32x4*)(lds + L3_FLG))[1]; fast = __builtin_amdgcn_readfirstlane((int)(f0_.x & f0_.y & f0_.z & f0_.w & f1_.x & f1_.y & f1_.z & f1_.w)) != 0; }
#define STEP0(FAST) do { _Pragma("unroll") for (int n = 0; n < 8; ++n) { const bf16x8 kf_ = KFRAG(n, 0); \
      if (n & 1) pA1 = MFMA32(kf_, qr[n >> 1], n == 1 ? ((FAST) ? f32x16{} : negm) : pA1); else pA0 = MFMA32(kf_, qr[n >> 1], n == 0 ? ((FAST) ? f32x16{} : negm) : pA0); } \
    if (NT <= 4) BANDADD(pA0, pA1, 0); \
    if (!(FAST)) { float a_ = MX3(pA0[0], pA0[1], pA1[0]), b_ = MX3(pA0[2], pA0[3], pA1[1]); a_ = MX3(a_, pA1[2], pA1[3]); \
      _Pragma("unroll") for (int r = 4; r < 16; r += 4) { a_ = MX3(a_, pA0[r], pA0[r + 1]); b_ = MX3(b_, pA0[r + 2], pA0[r + 3]); a_ = MX3(a_, pA1[r], pA1[r + 1]); b_ = MX3(b_, pA1[r + 2], pA1[r + 3]); } \
      float rm_ = __builtin_fmaxf(a_, b_); { auto rr = __builtin_amdgcn_permlane32_swap(__float_as_uint(rm_), __float_as_uint(rm_), false, false); rm_ = __builtin_fmaxf(__uint_as_float(rr[0]), __uint_as_float(rr[1])); } \
      MOVEREF(pA0, pA1, rm_); resc = false; }                               \
    _Pragma("unroll") for (int r = 0; r < 16; ++r) { pA0[r] = EX2(pA0[r]); pA1[r] = EX2(pA1[r]); } \
    if (2 < NT) DMA_K(2, 2); DMA_V(1, 1); \
    asm volatile("s_waitcnt vmcnt(4) lgkmcnt(0)\n\ts_barrier" ::: "memory"); } while (0)
#define STEP(FAST, STEADY, C0, C1, P0, P1, T, SL) do { const int t_ = (T), sl_ = (SL), prv_ = (sl_ == 0) ? 2 : sl_ - 1, nxt_ = (sl_ == 2) ? 0 : sl_ + 1; \
    const int ks_ = sl_ * SHM_K, vs_ = prv_ * SHM_V; float sacc = 0.f; SBAR(); \
    f[0] = KFRAG(0, ks_); f[1] = KFRAG(1, ks_); SBAR(); \
    _Pragma("unroll") for (int k = 0; k < 8; ++k) { \
      if (k + 2 < 8) f[(k + 2) & 3] = KFRAG(k + 2, ks_); else VFRAG(f[(k + 2) & 3], k + 2 - 8, vs_); \
      SBAR(); \
      if (k & 1) C1 = MFMA32(f[k & 3], qr[k >> 1], k == 1 ? ((FAST) ? f32x16{} : negm) : C1); else C0 = MFMA32(f[k & 3], qr[k >> 1], k == 0 ? ((FAST) ? f32x16{} : negm) : C0); \
      if (k < 4) { sacc += P0[4 * k]; sacc += P0[4 * k + 1]; sacc += P0[4 * k + 2]; sacc += P0[4 * k + 3]; } else { sacc += P1[4 * k - 16]; sacc += P1[4 * k - 15]; sacc += P1[4 * k - 14]; sacc += P1[4 * k - 13]; } \
      PIN(sacc); \
      { const unsigned c0_ = (k < 4) ? cvtpk(P0[4 * k], P0[4 * k + 1]) : cvtpk(P1[4 * k - 16], P1[4 * k - 15]), c1_ = (k < 4) ? cvtpk(P0[4 * k + 2], P0[4 * k + 3]) : cvtpk(P1[4 * k - 14], P1[4 * k - 13]); \
        if (k == 0) { pw0[0] = c0_; pw0[1] = c1_; } else if (k == 1) { pw0[2] = c0_; pw0[3] = c1_; PIN(pw0); } else if (k == 2) { pw1[0] = c0_; pw1[1] = c1_; } else if (k == 3) { pw1[2] = c0_; pw1[3] = c1_; PIN(pw1); } \
        else if (k == 4) { pw2[0] = c0_; pw2[1] = c1_; } else if (k == 5) { pw2[2] = c0_; pw2[3] = c1_; PIN(pw2); } else if (k == 6) { pw3[0] = c0_; pw3[1] = c1_; } else { pw3[2] = c0_; pw3[3] = c1_; PIN(pw3); } } \
      SBAR(); } \
    l_reg += sacc; \
    if ((STEADY) || t_ + 2 < NT) DMA_K(t_ + 2, prv_); if ((STEADY) || t_ + 1 < NT) DMA_V(t_ + 1, nxt_); \
    if (!(STEADY) && t_ >= NT - 4) BANDADD(C0, C1, t_); \
    float a_ = 0.f, b_ = 0.f, rm_ = 0.f; SBAR(); \
    _Pragma("unroll") for (int j = 0; j < 16; ++j) { \
      if (j + 2 < 16) VFRAG(f[(j + 10) & 3], j + 2, vs_); \
      SBAR(); \
      o[j >> 2] = MFMA32((j & 3) == 0 ? PWF(0) : (j & 3) == 1 ? PWF(1) : (j & 3) == 2 ? PWF(2) : PWF(3), f[(j + 8) & 3], o[j >> 2]); \
      if (FAST) { if (j < 8) { C0[2 * j] = EX2(C0[2 * j]); C0[2 * j + 1] = EX2(C0[2 * j + 1]); PIN(C0); } else { C1[2 * j - 16] = EX2(C1[2 * j - 16]); C1[2 * j - 15] = EX2(C1[2 * j - 15]); PIN(C1); } } \
      else if (j == 0) { a_ = MX3(C0[0], C0[1], C1[0]); b_ = MX3(C0[2], C0[3], C1[1]); a_ = MX3(a_, C1[2], C1[3]); a_ = MX3(a_, C0[4], C0[5]); b_ = MX3(b_, C0[6], C0[7]); PIN(a_); PIN(b_); } \
      else if (j == 1) { a_ = MX3(a_, C1[4], C1[5]); b_ = MX3(b_, C1[6], C1[7]); a_ = MX3(a_, C0[8], C0[9]); b_ = MX3(b_, C0[10], C0[11]); a_ = MX3(a_, C1[8], C1[9]); PIN(a_); PIN(b_); } \
      else if (j == 2) { b_ = MX3(b_, C1[10], C1[11]); a_ = MX3(a_, C0[12], C0[13]); b_ = MX3(b_, C0[14], C0[15]); a_ = MX3(a_, C1[12], C1[13]); b_ = MX3(b_, C1[14], C1[15]); PIN(a_); PIN(b_); } \
      else if (j == 3) { rm_ = __builtin_fmaxf(a_, b_); auto rr = __builtin_amdgcn_permlane32_swap(__float_as_uint(rm_), __float_as_uint(rm_), false, false); rm_ = __builtin_fmaxf(__uint_as_float(rr[0]), __uint_as_float(rr[1])); PIN(rm_); \
        SBAR(); if (__builtin_expect(__any(rm_ > THR), 0)) { MOVEREF(C0, C1, __builtin_fmaxf(rm_, 0.f)); } } \
      else if (j < 9) { const int e_ = 3 * (j - 4); C0[e_] = EX2(C0[e_]); C0[e_ + 1] = EX2(C0[e_ + 1]); C0[e_ + 2] = EX2(C0[e_ + 2]); if (j == 8) { C0[15] = EX2(C0[15]); } PIN(C0); } \
      else if (j < 14) { const int e_ = 3 * (j - 9); C1[e_] = EX2(C1[e_]); C1[e_ + 1] = EX2(C1[e_ + 1]); C1[e_ + 2] = EX2(C1[e_ + 2]); if (j == 13) { C1[15] = EX2(C1[15]); } PIN(C1); } \
      SBAR(); } \
    if (!(FAST)) RESC(); } while (0)
#define ENDW(T) do { if ((T) + 2 < NT) asm volatile("s_waitcnt vmcnt(4) lgkmcnt(0)\n\ts_barrier" ::: "memory"); else if ((T) + 1 < NT) asm volatile("s_waitcnt vmcnt(2) lgkmcnt(0)\n\ts_barrier" ::: "memory"); else asm volatile("s_waitcnt vmcnt(0) lgkmcnt(0)\n\ts_barrier" ::: "memory"); } while (0)
  int sl = 1;
#define ENDWS() asm volatile("s_waitcnt vmcnt(4) lgkmcnt(0)\n\ts_barrier" ::: "memory")
#define MAINLOOP(FAST) do { STEP0(FAST); int t = 1; \
    if (FAST) { _Pragma("unroll 1") for (; t + 10 <= NT; t += 6) { \
      STEP(FAST, true, pB0, pB1, pA0, pA1, t, 1); ENDWS(); STEP(FAST, true, pA0, pA1, pB0, pB1, t + 1, 2); ENDWS(); STEP(FAST, true, pB0, pB1, pA0, pA1, t + 2, 0); ENDWS(); \
      STEP(FAST, true, pA0, pA1, pB0, pB1, t + 3, 1); ENDWS(); STEP(FAST, true, pB0, pB1, pA0, pA1, t + 4, 2); ENDWS(); STEP(FAST, true, pA0, pA1, pB0, pB1, t + 5, 0); ENDWS(); } } \
    _Pragma("unroll 1") for (; t + 1 < NT; t += 2) { \
      STEP(FAST, false, pB0, pB1, pA0, pA1, t, sl); ENDW(t); sl = (sl == 2) ? 0 : sl + 1; \
      STEP(FAST, false, pA0, pA1, pB0, pB1, t + 1, sl); ENDW(t + 1); sl = (sl == 2) ? 0 : sl + 1; } \
    STEP(FAST, false, pB0, pB1, pA0, pA1, NT - 1, sl); ENDW(NT - 1); } while (0)
  if (fast) MAINLOOP(true); else MAINLOOP(false);
  { float sacc = 0.f;
    _Pragma("unroll") for (int r = 0; r < 16; ++r) { sacc += pB0[r]; sacc += pB1[r]; }
    l_reg += sacc;
    pw0 = (u32x4){cvtpk(pB0[0], pB0[1]), cvtpk(pB0[2], pB0[3]), cvtpk(pB0[4], pB0[5]), cvtpk(pB0[6], pB0[7])}; pw1 = (u32x4){cvtpk(pB0[8], pB0[9]), cvtpk(pB0[10], pB0[11]), cvtpk(pB0[12], pB0[13]), cvtpk(pB0[14], pB0[15])};
    pw2 = (u32x4){cvtpk(pB1[0], pB1[1]), cvtpk(pB1[2], pB1[3]), cvtpk(pB1[4], pB1[5]), cvtpk(pB1[6], pB1[7])}; pw3 = (u32x4){cvtpk(pB1[8], pB1[9]), cvtpk(pB1[10], pB1[11]), cvtpk(pB1[12], pB1[13]), cvtpk(pB1[14], pB1[15])};
    const int vs_ = sl * SHM_V;
    _Pragma("unroll") for (int j = 0; j < 16; ++j) { bf16x8 vf_; VFRAG(vf_, j, vs_); o[j >> 2] = MFMA32((j & 3) == 0 ? PWF(0) : (j & 3) == 1 ? PWF(1) : (j & 3) == 2 ? PWF(2) : PWF(3), vf_, o[j >> 2]); } }
  { auto rr = __builtin_amdgcn_permlane32_swap(__float_as_uint(l_reg), __float_as_uint(l_reg), false, false); l_reg = __uint_as_float(rr[0]) + __uint_as_float(rr[1]); }
  float* li_l = (float*)(lds + L3_WS) + wid * 64;
  float lam, gmul; { const __attribute__((address_space(1))) float* pp = (const __attribute__((address_space(1))) float*)par; int l2 = layer; asm volatile("" : "+s"(pp), "+s"(l2)); lam = pp[l2]; gmul = 1.f - ((l2 == 0) ? 0.2f : (0.8f - 0.6f * 0.7408182206817179f)); }
  if (hi == 0) li_l[r32] = l_reg; asm volatile("s_waitcnt lgkmcnt(0)" ::: "memory");
  float rli[16];
#pragma unroll
  for (int r = 0; r < 16; ++r) rli[r] = __builtin_amdgcn_rcpf(li_l[crow(r, hi)]);
  float* X = (float*)(lds + L_XCH + g * XCH_WAVE);
  BAR_L();
  attn_qload(qn, nb, nh, nqb, Zq, wid);
  if (map == 1) {
#pragma unroll
    for (int d0 = 0; d0 < 4; ++d0)
#pragma unroll
      for (int r = 0; r < 16; ++r) X[crow(r, hi) * XPITCH + d0 * 32 + r32] = o[d0][r] * rli[r];
  }
  BAR_L();
  if (map == 0) {
#pragma unroll
    for (int d0 = 0; d0 < 4; ++d0)
#pragma unroll
      for (int r = 0; r < 16; ++r) { float* xp = &X[crow(r, hi) * XPITCH + d0 * 32 + r32]; *xp = o[d0][r] * rli[r] - lam * (*xp); }
    asm volatile("s_waitcnt lgkmcnt(0)" ::: "memory");
    const f32x4* xr = (const f32x4*)(X + r32 * XPITCH + hi * 64);
    f32x4 v[16]; float ss = 0.f;
#pragma unroll
    for (int i = 0; i < 16; ++i) { v[i] = xr[i]; ss += (v[i][0] * v[i][0] + v[i][1] * v[i][1]) + (v[i][2] * v[i][2] + v[i][3] * v[i][3]); }
    { auto rr = __builtin_amdgcn_permlane32_swap(__float_as_uint(ss), __float_as_uint(ss), false, false); ss = __uint_as_float(rr[0]) + __uint_as_float(rr[1]); }
    const float rs = __builtin_amdgcn_rsqf(ss * (1.0f / 128.0f) + 1e-6f) * gmul;
    bf16* op = Oa + (rowbase + q0 + g * QBLK + r32) * PITCH + h * 128 + hi * 64;
    const f32x4* gp = (const f32x4*)(gsub + hi * 64);
#pragma unroll
    for (int i = 0; i < 16; i += 2) { const f32x4 g0 = gp[i], g1 = gp[i + 1]; u32x4 w;
      w.x = cvtpk(v[i][0] * rs * g0[0], v[i][1] * rs * g0[1]); w.y = cvtpk(v[i][2] * rs * g0[2], v[i][3] * rs * g0[3]);
      w.z = cvtpk(v[i + 1][0] * rs * g1[0], v[i + 1][1] * rs * g1[1]); w.w = cvtpk(v[i + 1][2] * rs * g1[2], v[i + 1][3] * rs * g1[3]);
      *(u32x4*)(op + i * 4) = w; }
  }
#undef DMA_K
#undef DMA_V
#undef KFRAG
#undef VFRAG
#undef PWF
#undef BANDADD
#undef MOVEREF
#undef RESC
#undef STEP
#undef STEP0
#undef ENDWS
#undef MAINLOOP
#undef ENDW
}
#undef PIN
#undef MFMA32
#undef MX3
#undef EX2
#undef BAR_L
#undef BAR_VL
#undef SBAR
}

constexpr int NWAVES = 8;
constexpr int BATCH = 2, SEQ = 16384, D = 1024, M = BATCH * SEQ, NHEAD = 8, INW = 8192, FFD = 2816, NEXP = 8, FFE = 3584;
constexpr float RMS_EPS = 1e-6f;
constexpr float C2 = 0.125f * 1.4426950408889634f;
constexpr int SLOTS = 2 * M + NEXP * 256;
constexpr float H8_SCALE = 8.f, WD8_SCALE = 1024.f;

constexpr size_t MiB = 1u << 20;
constexpr size_t WS_CTL = 0, CTL_ZERO_BYTES = 1 * MiB;
constexpr size_t WS_SSQP = 1 * MiB;
constexpr size_t WS_TOKE = 3 * MiB;
constexpr size_t WS_TOKG = WS_TOKE + (size_t)M * 4;
constexpr size_t WS_TOKR = WS_TOKG + (size_t)M * 8;
constexpr size_t WS_POS  = WS_TOKR + (size_t)M * 4;
constexpr size_t WS_RSG  = WS_POS + (size_t)M * 8;
constexpr size_t WS_PAR  = WS_RSG + (size_t)SLOTS * 4;
constexpr size_t WS_XS   = WS_PAR + 256;
constexpr size_t WS_WCS  = WS_XS + (size_t)M * 4;
constexpr size_t WS_GCS  = WS_WCS + 2 * 8192 * 4;
static_assert(WS_GCS + 5632 * 4 <= 5 * MiB, "small arrays");
constexpr size_t WS_WIN = 5 * MiB;
constexpr size_t WS_WSM = WS_WIN + 2 * (size_t)INW * D * 2;
constexpr size_t WS_WGU = WS_WSM + 6 * (size_t)D * D * 2;
constexpr size_t WS_WDN = WS_WGU + (size_t)2 * FFD * D * 2;
constexpr size_t WS_WEGU = WS_WDN + (size_t)D * FFD * 2;
constexpr size_t WS_WEDN = WS_WEGU + (size_t)NEXP * 2 * FFE * D * 2;
constexpr size_t WS_XQ = WS_WEGU + 56 * MiB;
constexpr size_t WS_XB = WS_WEDN + (size_t)NEXP * D * FFE * 2;
constexpr size_t WS_ARENA = WS_XB + (size_t)M * D * 2;
constexpr size_t ZG = (size_t)M * D * 2;
constexpr size_t WS_HD = WS_ARENA + 7 * ZG + ZG / 2;
constexpr size_t WS_XG = WS_ARENA;
constexpr size_t WS_HE = WS_XG + (size_t)SLOTS * D * 2;
constexpr size_t WS_END = WS_HE + (size_t)SLOTS * FFE * 2;
static_assert(WS_HD + (size_t)M * FFD <= WS_END && WS_END <= 896 * MiB, "d_ws map");
constexpr int CW_TMO = 0, CW_BAR = 4096, CW_CNT = 8192, CW_CUR = 8192 + 64, CW_WMAX = 8192 + 128, CW_COLMAX = 16384, CW_GUMAX = 16384 + 2 * 8192, CW_KMAX = CW_GUMAX + 5632, CW_XMAP = CW_KMAX + 64;

constexpr int RING_OFF = 0, RING_BYTES = 131072;
constexpr int LDSCTL_OFF = RING_BYTES, MISC_OFF = LDSCTL_OFF + 320;
constexpr int LDS_BYTES = 147456;
static_assert(MISC_OFF + 128 <= LDS_BYTES && dattn::LDS_BYTES <= RING_BYTES && dattn::LDS3_BYTES <= RING_BYTES, "LDS map");

#define GAS __attribute__((address_space(1)))
#define LAS __attribute__((address_space(3)))
typedef unsigned short bf16;
typedef unsigned v4u __attribute__((ext_vector_type(4)));
typedef float f32x4 __attribute__((ext_vector_type(4)));
typedef short bf16x8 __attribute__((ext_vector_type(8)));
typedef GAS unsigned gu32;
typedef GAS unsigned long long gu64;
#define RLX_AGENT __ATOMIC_RELAXED, __HIP_MEMORY_SCOPE_AGENT
#define LDS_WAIT() asm volatile("s_waitcnt lgkmcnt(0)" ::: "memory")
#define VM_WAIT() asm volatile("s_waitcnt vmcnt(0)" ::: "memory")
__device__ __forceinline__ unsigned long long rt() { return __builtin_amdgcn_s_memrealtime(); }
__device__ __forceinline__ unsigned f2bf(float f) { unsigned u = __builtin_bit_cast(unsigned, f); return (u + 0x7fffu + ((u >> 16) & 1u)) >> 16; }
__device__ __forceinline__ unsigned pk2(float lo, float hi) { return f2bf(lo) | (f2bf(hi) << 16); }

#define XB_TMO      128
#define XB_XCNT(j)  (256  + 64 * (j))
#define XB_XSUB(j)  (1280 + 64 * (j))
#define XB_XGEN(j)  (2304 + 64 * (j))
#define XB_TOP      3328
#define XB_TOPGEN   3392
#define XCD_BAR_WORDS 3456
#define XB_LSUB(j)  (3456 + 16 * (j))
#define XB_LGEN(j)  (3712 + 16 * (j))
#define XB_SPIN_CAP (1u << 18)

__device__ __forceinline__ unsigned xb_ld(unsigned* p)              { return __hip_atomic_load(p, __ATOMIC_RELAXED, __HIP_MEMORY_SCOPE_AGENT); }
__device__ __forceinline__ unsigned xb_add(unsigned* p, unsigned v) { return __hip_atomic_fetch_add(p, v, __ATOMIC_RELAXED, __HIP_MEMORY_SCOPE_AGENT); }
__device__ __forceinline__ unsigned xb_xcc_id() { return (unsigned)__builtin_amdgcn_s_getreg((3 << 11) | 20) & 0xFu; }
#define XB_SPIN(cond, bar) do { unsigned _sp = 0; while (cond) { __builtin_amdgcn_s_sleep(1); \
    if ((++_sp & 255u) == 0u) { if (xb_ld(&(bar)[XB_TMO])) break; if (_sp > XB_SPIN_CAP) { atomicAdd(&(bar)[XB_TMO], 1u); break; } } } } while (0)

struct XcdBarrier {
    unsigned* bar; unsigned x;
    volatile LAS unsigned* st;
};

__device__ __forceinline__ XcdBarrier xcd_barrier_post(unsigned* bar, volatile LAS unsigned* st) {
    XcdBarrier b; b.bar = bar; b.x = xb_xcc_id(); b.st = st;
    if (threadIdx.x == 0) (void)xb_add(&bar[XB_XCNT(b.x)], 1u);
    return b;
}
__device__ __forceinline__ void xcd_barrier_complete(unsigned* bar, unsigned x, unsigned& nloc, unsigned& nx) {
    const unsigned G = gridDim.x * gridDim.y * gridDim.z;
    unsigned sum, cnt, mine, sp = 0u;
    for (;;) {
        sum = 0u; cnt = 0u; mine = 0u;
#pragma unroll
        for (unsigned j = 0; j < 16; ++j) { const unsigned c = xb_ld(&bar[XB_XCNT(j)]); sum += c; cnt += (c > 0u) ? 1u : 0u; mine = (j == x) ? c : mine; }
        if (sum == G) break;
        __builtin_amdgcn_s_sleep(1);
        if ((++sp & 255u) == 0u) { if (xb_ld(&bar[XB_TMO])) break; if (sp > XB_SPIN_CAP) { atomicAdd(&bar[XB_TMO], 1u); break; } }
    }
    nloc = mine > 0u ? mine : 1u; nx = cnt > 0u ? cnt : 1u;
}

__device__ __forceinline__ void xcd_barrier(const XcdBarrier& b) {
    asm volatile("s_waitcnt vmcnt(0)" ::: "memory");
    __syncthreads();
    if (threadIdx.x == 0) {
        unsigned* bar = b.bar;
        __builtin_amdgcn_s_waitcnt(0);
        unsigned nloc = b.st[0], nx = b.st[1];
        if (nloc == 0u) { xcd_barrier_complete(bar, b.x, nloc, nx); b.st[0] = nloc; b.st[1] = nx; }
        const unsigned old = xb_add(&bar[XB_XSUB(b.x)], 1u);
        const unsigned gen = old / nloc;
        if (old + 1u == (gen + 1u) * nloc) {
            __builtin_amdgcn_fence(__ATOMIC_RELEASE, "agent");
            asm volatile("s_waitcnt vmcnt(0)" ::: "memory");
            const unsigned og = xb_add(&bar[XB_TOP], 1u);
            const unsigned tg = og / nx;
            if (og + 1u == (tg + 1u) * nx) xb_add(&bar[XB_TOPGEN], 1u);
            else XB_SPIN(xb_ld(&bar[XB_TOPGEN]) == tg, bar);
            __builtin_amdgcn_fence(__ATOMIC_ACQUIRE, "agent");
            xb_add(&bar[XB_XGEN(b.x)], 1u);
            asm volatile("s_waitcnt vmcnt(0)" ::: "memory");
        } else {
            XB_SPIN(xb_ld(&bar[XB_XGEN(b.x)]) == gen, bar);
            __builtin_amdgcn_fence(__ATOMIC_ACQUIRE, "agent");
            asm volatile("s_waitcnt vmcnt(0)" ::: "memory");
        }
    }
    __syncthreads();
}

__device__ __forceinline__ void xcd_barrier_local(const XcdBarrier& b) {
    asm volatile("s_waitcnt vmcnt(0)" ::: "memory");
    __syncthreads();
    if (threadIdx.x == 0) {
        unsigned* bar = b.bar;
        __builtin_amdgcn_s_waitcnt(0);
        const unsigned nloc = b.st[0];
        const unsigned old = xb_add(&bar[XB_LSUB(b.x)], 1u);
        const unsigned gen = old / nloc;
        if (old + 1u == (gen + 1u) * nloc) xb_add(&bar[XB_LGEN(b.x)], 1u);
        else XB_SPIN(xb_ld(&bar[XB_LGEN(b.x)]) == gen, bar);
        __builtin_amdgcn_fence(__ATOMIC_ACQUIRE, "agent");
        asm volatile("s_waitcnt vmcnt(0)" ::: "memory");
    }
    __syncthreads();
}

struct Frame {
    LAS unsigned char* lds;
    volatile LAS unsigned* MISC;
    int tid, lane, wave;
    int vcu, G;
};
__device__ __forceinline__ Frame refresh(const Frame& F0) { Frame F = F0; int l_; asm volatile("v_mbcnt_lo_u32_b32 %0, -1, 0\n\tv_mbcnt_hi_u32_b32 %0, -1, %0" : "=v"(l_)); F.lane = l_; F.tid = F0.wave * 64 + l_; return F; }
typedef unsigned u32x2_t __attribute__((ext_vector_type(2)));
typedef float f32x2_t __attribute__((ext_vector_type(2)));
typedef int i32x2_t __attribute__((ext_vector_type(2)));
__device__ __forceinline__ float wave_sum(float v) {
#pragma unroll
    for (int o = 1; o < 64; o <<= 1) v += __shfl_xor(v, o);
    return v;
}
__device__ __forceinline__ void unpack8(const v4u w, float (&f)[8]) {
    f[0] = __uint_as_float(w.x << 16); f[1] = __uint_as_float(w.x & 0xffff0000u); f[2] = __uint_as_float(w.y << 16); f[3] = __uint_as_float(w.y & 0xffff0000u);
    f[4] = __uint_as_float(w.z << 16); f[5] = __uint_as_float(w.z & 0xffff0000u); f[6] = __uint_as_float(w.w << 16); f[7] = __uint_as_float(w.w & 0xffff0000u);
}
__device__ __forceinline__ void p0_transpose_item(const float* W, int K, int N, bf16* WT, int orow0, int k0, int n0, const float* gk, float cs, LAS float* scr, int lane) {
#pragma unroll 32
    for (int i = 0; i < 32; ++i) { const int kk = 2 * i + (lane >> 5); const float s = gk ? gk[k0 + kk] * cs : cs; scr[kk * 33 + (lane & 31)] = W[(size_t)(k0 + kk) * N + n0 + (lane & 31)] * s; }
    LDS_WAIT(); asm volatile("" ::: "memory");
    const int c = lane & 7;
#pragma unroll
    for (int j = 0; j < 4; ++j) { const int n = (lane >> 3) + 8 * j; const LAS float* s = scr + (8 * c) * 33 + n;
        v4u o; o.x = pk2(s[0 * 33], s[1 * 33]); o.y = pk2(s[2 * 33], s[3 * 33]); o.z = pk2(s[4 * 33], s[5 * 33]); o.w = pk2(s[6 * 33], s[7 * 33]);
        *(GAS v4u*)(WT + (size_t)(orow0 + n) * K + k0 + 8 * c) = o; }
    LDS_WAIT(); asm volatile("" ::: "memory");
}
__device__ __forceinline__ int win_row(int n0) { if (n0 < 3072 || n0 >= 6144) return n0; if (n0 < 4096) { const int j = (n0 - 3072) >> 7, i = (n0 - 3072) & 127; return 3072 + 256 * j + i; }
    if (n0 < 5120) { const int blk = (n0 - 4096) >> 7, i = (n0 - 4096) & 127; return 5120 + 256 * (blk & 3) + 128 * (blk >> 2) + i; }
    const int j = (n0 - 5120) >> 7, i = (n0 - 5120) & 127; return 3072 + 256 * j + 128 + i; }
__device__ __forceinline__ int gu_row(int n0, int F) { const int bj = n0 / F, j = n0 - bj * F; return 256 * (j >> 7) + 128 * bj + (j & 127); }

struct Args { const float* in[17]; float* out; unsigned char* ws; };
#define AS4 __attribute__((address_space(4)))
__device__ __forceinline__ const AS4 Args* kargs() { const AS4 Args* p = (const AS4 Args*)__builtin_amdgcn_kernarg_segment_ptr(); asm volatile("" : "+s"(p)); return p; }
enum { I_X = 0, I_RELB, I_MIXG, I_WIN, I_LAMQK, I_SUBLN, I_CONVW, I_WOA, I_WOC, I_WO, I_FFNG, I_DGU, I_DDN, I_ROUTER, I_EGU, I_EDN, I_FING };

__device__ __forceinline__ void winq_local(const Frame& F, const AS4 Args* A_) {
    unsigned char* const Fws = A_->ws; const float* W = A_->in[I_WIN]; const float* gk = A_->in[I_MIXG];
    LAS float* scr = (LAS float*)(F.lds + RING_OFF + F.wave * 16384);
#pragma unroll 1
    for (int nb = F.vcu; nb < 256; nb += F.G) { const int n0 = 32 * nb, r0 = win_row(n0);
        float val[2][32]; float mx = 0.f;
#pragma unroll
        for (int h = 0; h < 2; ++h) { const int k0 = 64 * (F.wave + 8 * h);
#pragma unroll
            for (int i = 0; i < 32; ++i) { const int kk = k0 + 2 * i + (F.lane >> 5); val[h][i] = W[(size_t)kk * INW + n0 + (F.lane & 31)] * gk[kk]; } }
#pragma unroll
        for (int h = 0; h < 2; ++h)
#pragma unroll
            for (int i = 0; i < 32; ++i) mx = fmaxf(mx, fabsf(val[h][i]));
        mx = fmaxf(mx, __shfl_xor(mx, 32));
        if (F.lane < 32) scr[3072 + F.lane] = mx;
        __syncthreads();
        float cm = 0.f;
#pragma unroll
        for (int w = 0; w < 8; ++w) cm = fmaxf(cm, ((LAS float*)(F.lds + RING_OFF + w * 16384))[3072 + (F.lane & 31)]);
        const float inv = cm > 0.f ? 127.f / cm : 0.f;
        if (F.wave == 0 && F.lane < 32) ((float*)(Fws + WS_WCS))[r0 + F.lane] = cm * (1.0f / 127.0f);
#pragma unroll
        for (int h = 0; h < 2; ++h) { const int k0 = 64 * (F.wave + 8 * h);
#pragma unroll
            for (int i = 0; i < 32; ++i) { const int kk = 2 * i + (F.lane >> 5); scr[kk * 33 + (F.lane & 31)] = val[h][i] * inv; }
            LDS_WAIT(); asm volatile("" ::: "memory");
            const int n = F.lane >> 1, hf = F.lane & 1; const LAS float* s = scr + (32 * hf) * 33 + n; unsigned w[8];
#pragma unroll
            for (int j = 0; j < 8; ++j) { const int q0 = (int)rintf(s[(4 * j + 0) * 33]), q1 = (int)rintf(s[(4 * j + 1) * 33]), q2 = (int)rintf(s[(4 * j + 2) * 33]), q3 = (int)rintf(s[(4 * j + 3) * 33]);
                w[j] = (unsigned)(q0 & 255) | ((unsigned)(q1 & 255) << 8) | ((unsigned)(q2 & 255) << 16) | ((unsigned)(q3 & 255) << 24); }
            unsigned char* dst = Fws + WS_WIN + ((size_t)r0 + n) * D + k0 + 32 * hf;
            *(GAS v4u*)dst = (v4u){w[0], w[1], w[2], w[3]}; *(GAS v4u*)(dst + 16) = (v4u){w[4], w[5], w[6], w[7]};
            LDS_WAIT(); asm volatile("" ::: "memory"); }
        __syncthreads();
    }
}

__device__ __forceinline__ void p0_prologue(const Frame& F0) {
    const Frame F = refresh(F0);
    const AS4 Args* A_ = kargs(); const AS4 Args& A = *A_; unsigned char* const Fws = A.ws;
    LAS float* scr = (LAS float*)(F.lds + RING_OFF + F.wave * 16384);
    const int gw = F.vcu * NWAVES + F.wave, NGW = F.G * NWAVES;
    winq_local(F, A_);
    constexpr int I_A = 16 * 256, I_B = 6 * 512, I_C = 16 * 176, I_D = 44 * 32, I_E = 8 * 16 * 224, I_F = 8 * 56 * 32;
    constexpr int NITEMS = I_A + I_B + I_C + I_D + I_E + I_F;
    for (int it = gw; it < NITEMS; it += NGW) {
        int r = it;
        if (r < I_A) { const int l = 1, rr = r, kb = rr / 256, nb = rr % 256;
            const float* W = A.in[I_WIN] + (size_t)l * D * INW; const float* gk = A.in[I_MIXG] + l * D; float mx = 0.f;
#pragma unroll 32
            for (int i = 0; i < 32; ++i) { const int kk = 64 * kb + 2 * i + (F.lane >> 5); mx = fmaxf(mx, fabsf(W[(size_t)kk * INW + 32 * nb + (F.lane & 31)] * gk[kk])); }
            mx = fmaxf(mx, __shfl_xor(mx, 32));
            if (F.lane < 32) __hip_atomic_fetch_max((unsigned*)((gu32*)(Fws + WS_CTL) + CW_COLMAX) + l * INW + win_row(32 * nb) + F.lane, __float_as_uint(mx), __ATOMIC_RELAXED, __HIP_MEMORY_SCOPE_AGENT);
            continue; }
        r -= I_A;
        if (r < I_B) { const int idx = r / 512, rr = r % 512, l = idx / 3, which = idx % 3, kb = rr / 32, nb = rr % 32;
            const float* W = (which == 0 ? A.in[I_WOA] : which == 1 ? A.in[I_WOC] : A.in[I_WO]) + (size_t)l * D * D;
            p0_transpose_item(W, D, D, (bf16*)(Fws + WS_WSM) + (size_t)idx * D * D, 32 * nb, 64 * kb, 32 * nb, nullptr, 1.f, scr, F.lane); continue; }
        r -= I_B;
        if (r < I_C) { const int kb = r / 176, nb = r % 176;
            const float* W = A.in[I_DGU]; const float* gk = A.in[I_FFNG]; float mx = 0.f;
#pragma unroll 32
            for (int i = 0; i < 32; ++i) { const int kk = 64 * kb + 2 * i + (F.lane >> 5); mx = fmaxf(mx, fabsf(W[(size_t)kk * (2 * FFD) + 32 * nb + (F.lane & 31)] * gk[kk])); }
            mx = fmaxf(mx, __shfl_xor(mx, 32));
            if (F.lane < 32) __hip_atomic_fetch_max((unsigned*)((gu32*)(Fws + WS_CTL) + CW_GUMAX) + gu_row(32 * nb, FFD) + F.lane, __float_as_uint(mx), __ATOMIC_RELAXED, __HIP_MEMORY_SCOPE_AGENT);
            continue; }
        r -= I_C;
        if (r < I_D) { const int kb = r / 32, nb = r % 32, k0 = 64 * kb, n0 = 32 * nb;
            const float* W = A.in[I_DDN];
#pragma unroll 32
            for (int i = 0; i < 32; ++i) { const int kk = 2 * i + (F.lane >> 5); scr[kk * 33 + (F.lane & 31)] = fminf(fmaxf(W[(size_t)(k0 + kk) * D + n0 + (F.lane & 31)] * WD8_SCALE, -448.f), 448.f); }
            LDS_WAIT(); asm volatile("" ::: "memory");
            const int n = F.lane >> 1, hf = F.lane & 1; const LAS float* s = scr + (32 * hf) * 33 + n; unsigned w[8];
#pragma unroll
            for (int j = 0; j < 8; ++j) w[j] = pg8::pack4_fp8(s[(4 * j + 0) * 33], s[(4 * j + 1) * 33], s[(4 * j + 2) * 33], s[(4 * j + 3) * 33]);
            unsigned char* dst = Fws + WS_WDN + ((size_t)(n0 + n)) * FFD + k0 + 32 * hf;
            *(GAS v4u*)dst = (v4u){w[0], w[1], w[2], w[3]}; *(GAS v4u*)(dst + 16) = (v4u){w[4], w[5], w[6], w[7]};
            LDS_WAIT(); asm volatile("" ::: "memory"); continue; }
        r -= I_D;
        if (r < I_E) continue;
        r -= I_E;
        { const int e = r / 1792, rr = r % 1792, kb = rr / 32, nb = rr % 32, k0 = 64 * kb, n0 = 32 * nb;
            const float* W = A.in[I_EDN] + (size_t)e * FFE * D;
#pragma unroll 32
            for (int i = 0; i < 32; ++i) { const int kk = 2 * i + (F.lane >> 5); scr[kk * 33 + (F.lane & 31)] = fminf(fmaxf(W[(size_t)(k0 + kk) * D + n0 + (F.lane & 31)] * WD8_SCALE, -448.f), 448.f); }
            LDS_WAIT(); asm volatile("" ::: "memory");
            const int n = F.lane >> 1, hf = F.lane & 1; const LAS float* s = scr + (32 * hf) * 33 + n; unsigned w[8];
#pragma unroll
            for (int j = 0; j < 8; ++j) w[j] = pg8::pack4_fp8(s[(4 * j + 0) * 33], s[(4 * j + 1) * 33], s[(4 * j + 2) * 33], s[(4 * j + 3) * 33]);
            unsigned char* dst = Fws + WS_WEDN + ((size_t)e * D + n0 + n) * FFE + k0 + 32 * hf;
            *(GAS v4u*)dst = (v4u){w[0], w[1], w[2], w[3]}; *(GAS v4u*)(dst + 16) = (v4u){w[4], w[5], w[6], w[7]};
            LDS_WAIT(); asm volatile("" ::: "memory"); }
    }
    for (int s4 = gw; s4 < 4 * 8 * 64; s4 += NGW) if ((s4 & 3) == 0) { const int sj = s4 >> 2, e = sj >> 6, k = 16 * (sj & 63); const float* W = A.in[I_EGU] + (size_t)e * D * 2 * FFE + (size_t)k * (2 * FFE); const float gkk = A.in[I_FFNG][D + k];
        float mx = 0.f; f32x4 v[28];
#pragma unroll
        for (int i = 0; i < 28; ++i) v[i] = *(const f32x4*)(W + F.lane * 4 + 256 * i);
#pragma unroll
        for (int i = 0; i < 28; ++i) mx = fmaxf(fmaxf(mx, fmaxf(fabsf(v[i][0]), fabsf(v[i][1]))), fmaxf(fabsf(v[i][2]), fabsf(v[i][3])));
        mx *= fabsf(gkk);
#pragma unroll
        for (int o = 1; o < 64; o <<= 1) mx = fmaxf(mx, __shfl_xor(mx, o));
        if (F.lane == 0) __hip_atomic_fetch_max((unsigned*)((gu32*)(Fws + WS_CTL) + CW_WMAX) + 64 * e, __float_as_uint(mx * 1.25f), __ATOMIC_RELAXED, __HIP_MEMORY_SCOPE_AGENT); }
    const float* x = A.in[I_X]; unsigned char* XQ = Fws + WS_XQ; float* xsc = (float*)(Fws + WS_XS); float* ssqp = (float*)(Fws + WS_SSQP);
#pragma unroll 1
    for (int mb = gw; mb < M; mb += 4 * NGW) {
        f32x4 v[4][4]; float s[4], mx[4];
#pragma unroll
        for (int k = 0; k < 4; ++k) { const int m = (mb + k * NGW < M) ? mb + k * NGW : mb; const GAS f32x4* xr = (const GAS f32x4*)(x + (size_t)m * D) + F.lane;
#pragma unroll
            for (int j = 0; j < 4; ++j) v[k][j] = xr[64 * j]; }
#pragma unroll
        for (int k = 0; k < 4; ++k) { s[k] = 0.f; mx[k] = 0.f;
#pragma unroll
            for (int j = 0; j < 4; ++j) { s[k] += (v[k][j].x * v[k][j].x + v[k][j].y * v[k][j].y) + (v[k][j].z * v[k][j].z + v[k][j].w * v[k][j].w);
                mx[k] = fmaxf(fmaxf(mx[k], fmaxf(fabsf(v[k][j].x), fabsf(v[k][j].y))), fmaxf(fabsf(v[k][j].z), fabsf(v[k][j].w))); } }
#pragma unroll
        for (int o = 1; o < 64; o <<= 1)
#pragma unroll
            for (int k = 0; k < 4; ++k) { s[k] += __shfl_xor(s[k], o); mx[k] = fmaxf(mx[k], __shfl_xor(mx[k], o)); }
#pragma unroll
        for (int k = 0; k < 4; ++k) { if (mb + k * NGW < M) { const int m = mb + k * NGW;
            const float sa = mx[k] > 0.f ? mx[k] * (1.0f / 127.0f) : 1.f, inv = 1.0f / sa;
            GAS unsigned* o4 = (GAS unsigned*)(XQ + (size_t)m * D) + F.lane;
#pragma unroll
            for (int j = 0; j < 4; ++j) { const int q0 = (int)rintf(v[k][j].x * inv), q1 = (int)rintf(v[k][j].y * inv), q2 = (int)rintf(v[k][j].z * inv), q3 = (int)rintf(v[k][j].w * inv);
                o4[64 * j] = (unsigned)(q0 & 255) | ((unsigned)(q1 & 255) << 8) | ((unsigned)(q2 & 255) << 16) | ((unsigned)(q3 & 255) << 24); }
            if (F.lane == 0) xsc[m] = sa / sqrtf(s[k] * (1.0f / D) + RMS_EPS); } }
    }
    if (gw == 0) {
        float* par = (float*)(Fws + WS_PAR);
#pragma unroll
        for (int l = 0; l < 2; ++l) { const float* lq = A.in[I_LAMQK] + l * 256;
            const float sa = wave_sum(lq[F.lane] * lq[64 + F.lane]), sb = wave_sum(lq[128 + F.lane] * lq[192 + F.lane]);
            const float lam_init = (l == 0) ? 0.2f : (0.8f - 0.6f * 0.7408182206817179f);
            if (F.lane == 0) par[l] = expf(sa) - expf(sb) + lam_init; }
    }
}

__device__ __forceinline__ void conv_phase(const Frame& F0, int l) {
    const Frame F = refresh(F0);
    const AS4 Args* A_ = kargs(); unsigned char* const Fws = A_->ws; const float* cw = A_->in[I_CONVW] + (size_t)l * 3 * D;
    const bf16* Uu = (const bf16*)(Fws + WS_ARENA + 3 * ZG); bf16* Bb = (bf16*)(Fws + WS_ARENA + 4 * ZG);
    const int nthr = F.G * NWAVES * 64, gt = F.vcu * NWAVES * 64 + F.tid;
    if (F.G == 256) {
        const bf16* Bh = (const bf16*)(Fws + WS_SSQP);
        for (int idx = gt; idx < (M / 256) * 2 * 128; idx += nthr) {
            const int pr = idx >> 7, col = (idx & 127) * 8, m = (pr >> 1) * 256 + (pr & 1), t = m & (SEQ - 1); const size_t o = (size_t)m * D + col;
            float u0[8], u1[8], u2[8], bb[8];
            unpack8(*(const v4u*)(Uu + o), u0); unpack8(*(const v4u*)(Bh + (size_t)pr * D + col), bb);
            if (t >= 1) unpack8(*(const v4u*)(Uu + o - D), u1); else {
#pragma unroll
                for (int i = 0; i < 8; ++i) u1[i] = 0.f; }
            if (t >= 2) unpack8(*(const v4u*)(Uu + o - 2 * D), u2); else {
#pragma unroll
                for (int i = 0; i < 8; ++i) u2[i] = 0.f; }
            float r[8];
#pragma unroll
            for (int i = 0; i < 8; ++i) r[i] = bb[i] * (cw[col + i] * u2[i] + cw[D + col + i] * u1[i] + cw[2 * D + col + i] * u0[i]);
            v4u w; w.x = pk2(r[0], r[1]); w.y = pk2(r[2], r[3]); w.z = pk2(r[4], r[5]); w.w = pk2(r[6], r[7]);
            *(v4u*)(Bb + o) = w;
        }
        return;
    }
    for (int idx = gt; idx < M * 128; idx += nthr) {
        const int m = idx >> 7, col = (idx & 127) * 8, t = m & (SEQ - 1); const size_t o = (size_t)m * D + col;
        float u0[8], u1[8], u2[8], bb[8];
        unpack8(*(const v4u*)(Uu + o), u0); unpack8(*(const v4u*)(Bb + o), bb);
        if (t >= 1) unpack8(*(const v4u*)(Uu + o - D), u1); else {
#pragma unroll
            for (int i = 0; i < 8; ++i) u1[i] = 0.f; }
        if (t >= 2) unpack8(*(const v4u*)(Uu + o - 2 * D), u2); else {
#pragma unroll
            for (int i = 0; i < 8; ++i) u2[i] = 0.f; }
        float r[8];
#pragma unroll
        for (int i = 0; i < 8; ++i) r[i] = bb[i] * (cw[col + i] * u2[i] + cw[D + col + i] * u1[i] + cw[2 * D + col + i] * u0[i]);
        v4u w; w.x = pk2(r[0], r[1]); w.y = pk2(r[2], r[3]); w.z = pk2(r[4], r[5]); w.w = pk2(r[6], r[7]);
        *(v4u*)(Bb + o) = w;
    }
}

__device__ __forceinline__ void winq_items(const Frame& F, const AS4 Args* A_, int l) {
    unsigned char* const Fws = A_->ws; const float* W = A_->in[I_WIN] + (size_t)l * D * INW; const float* gk = A_->in[I_MIXG] + l * D;
    LAS float* scr = (LAS float*)(F.lds + RING_OFF + F.wave * 16384);
    const unsigned* cmx = (const unsigned*)((gu32*)(Fws + WS_CTL) + CW_COLMAX) + l * INW;
    const int gw = F.vcu * NWAVES + F.wave, NGW = F.G * NWAVES;
    for (int it = gw; it < 16 * 256; it += NGW) { const int kb = it / 256, nb = it % 256, k0 = 64 * kb, n0 = 32 * nb, r0 = win_row(n0);
        const float cm = __uint_as_float(__hip_atomic_load(cmx + r0 + (F.lane & 31), __ATOMIC_RELAXED, __HIP_MEMORY_SCOPE_AGENT)), inv = cm > 0.f ? 127.f / cm : 0.f;
        if (kb == 0 && F.lane < 32) ((float*)(Fws + WS_WCS))[l * INW + r0 + F.lane] = cm * (1.0f / 127.0f);
#pragma unroll 32
        for (int i = 0; i < 32; ++i) { const int kk = 2 * i + (F.lane >> 5); scr[kk * 33 + (F.lane & 31)] = W[(size_t)(k0 + kk) * INW + n0 + (F.lane & 31)] * gk[k0 + kk] * inv; }
        LDS_WAIT(); asm volatile("" ::: "memory");
        const int n = F.lane >> 1, hf = F.lane & 1; const LAS float* s = scr + (32 * hf) * 33 + n; unsigned w[8];
#pragma unroll
        for (int j = 0; j < 8; ++j) { const int q0 = (int)rintf(s[(4 * j + 0) * 33]), q1 = (int)rintf(s[(4 * j + 1) * 33]), q2 = (int)rintf(s[(4 * j + 2) * 33]), q3 = (int)rintf(s[(4 * j + 3) * 33]);
            w[j] = (unsigned)(q0 & 255) | ((unsigned)(q1 & 255) << 8) | ((unsigned)(q2 & 255) << 16) | ((unsigned)(q3 & 255) << 24); }
        unsigned char* dst = Fws + WS_WIN + ((size_t)l * INW + r0 + n) * D + k0 + 32 * hf;
        *(GAS v4u*)dst = (v4u){w[0], w[1], w[2], w[3]}; *(GAS v4u*)(dst + 16) = (v4u){w[4], w[5], w[6], w[7]};
        LDS_WAIT(); asm volatile("" ::: "memory");
    }
}
__device__ __forceinline__ void dgq_items(const Frame& F, const AS4 Args* A_) {
    unsigned char* const Fws = A_->ws; const float* W = A_->in[I_DGU]; const float* gk = A_->in[I_FFNG];
    LAS float* scr = (LAS float*)(F.lds + RING_OFF + F.wave * 16384);
    const unsigned* cmx = (const unsigned*)((gu32*)(Fws + WS_CTL) + CW_GUMAX);
    const int gw = F.vcu * NWAVES + F.wave, NGW = F.G * NWAVES;
    for (int it = gw; it < 16 * 176; it += NGW) { const int kb = it / 176, nb = it % 176, k0 = 64 * kb, n0 = 32 * nb, r0 = gu_row(n0, FFD);
        const float cm = __uint_as_float(__hip_atomic_load(cmx + r0 + (F.lane & 31), __ATOMIC_RELAXED, __HIP_MEMORY_SCOPE_AGENT)), inv = cm > 0.f ? 127.f / cm : 0.f;
        if (kb == 0 && F.lane < 32) ((float*)(Fws + WS_GCS))[r0 + F.lane] = cm * (1.0f / 127.0f);
#pragma unroll 32
        for (int i = 0; i < 32; ++i) { const int kk = 2 * i + (F.lane >> 5); scr[kk * 33 + (F.lane & 31)] = W[(size_t)(k0 + kk) * (2 * FFD) + n0 + (F.lane & 31)] * gk[k0 + kk] * inv; }
        LDS_WAIT(); asm volatile("" ::: "memory");
        const int n = F.lane >> 1, hf = F.lane & 1; const LAS float* s = scr + (32 * hf) * 33 + n; unsigned w[8];
#pragma unroll
        for (int j = 0; j < 8; ++j) { const int q0 = (int)rintf(s[(4 * j + 0) * 33]), q1 = (int)rintf(s[(4 * j + 1) * 33]), q2 = (int)rintf(s[(4 * j + 2) * 33]), q3 = (int)rintf(s[(4 * j + 3) * 33]);
            w[j] = (unsigned)(q0 & 255) | ((unsigned)(q1 & 255) << 8) | ((unsigned)(q2 & 255) << 16) | ((unsigned)(q3 & 255) << 24); }
        unsigned char* dst = Fws + WS_WGU + ((size_t)r0 + n) * D + k0 + 32 * hf;
        *(GAS v4u*)dst = (v4u){w[0], w[1], w[2], w[3]}; *(GAS v4u*)(dst + 16) = (v4u){w[4], w[5], w[6], w[7]};
        LDS_WAIT(); asm volatile("" ::: "memory");
    }
}
__device__ __forceinline__ void winq_phase(const Frame& F0, int l) { const Frame F = refresh(F0); winq_items(F, kargs(), l); }
__device__ __forceinline__ void wq_phase(const Frame& F0) {
    const Frame F = refresh(F0);
    const AS4 Args* A_ = kargs(); unsigned char* const Fws = A_->ws; const float* Wall = A_->in[I_EGU]; const float* gk = A_->in[I_FFNG] + D;
    dgq_items(F, A_);
    winq_items(F, A_, 1);
    LAS float* scr = (LAS float*)(F.lds + RING_OFF + F.wave * 16384);
    const int gw = F.vcu * NWAVES + F.wave, NGW = F.G * NWAVES;
    for (int it = gw; it < 8 * 16 * 224; it += NGW) {
        const int e = it / 3584, rr = it % 3584, kb = rr / 224, nb = rr % 224, k0 = 64 * kb, n0 = 32 * nb;
        const float wmax = __uint_as_float(__hip_atomic_load((unsigned*)((gu32*)(Fws + WS_CTL) + CW_WMAX) + 64 * e, __ATOMIC_RELAXED, __HIP_MEMORY_SCOPE_AGENT));
        const float inv = wmax > 0.f ? 127.f / wmax : 0.f;
        const float* W = Wall + (size_t)e * D * 2 * FFE;
#pragma unroll 32
        for (int i = 0; i < 32; ++i) { const int kk = 2 * i + (F.lane >> 5); scr[kk * 33 + (F.lane & 31)] = W[(size_t)(k0 + kk) * (2 * FFE) + n0 + (F.lane & 31)] * gk[k0 + kk] * inv; }
        LDS_WAIT(); asm volatile("" ::: "memory");
        const int n = F.lane >> 1, hf = F.lane & 1; const LAS float* s = scr + (32 * hf) * 33 + n;
        unsigned w[8];
#pragma unroll
        for (int j = 0; j < 8; ++j) { const int q0 = (int)rintf(fminf(fmaxf(s[(4 * j + 0) * 33], -127.f), 127.f)), q1 = (int)rintf(fminf(fmaxf(s[(4 * j + 1) * 33], -127.f), 127.f)), q2 = (int)rintf(fminf(fmaxf(s[(4 * j + 2) * 33], -127.f), 127.f)), q3 = (int)rintf(fminf(fmaxf(s[(4 * j + 3) * 33], -127.f), 127.f));
            w[j] = (unsigned)(q0 & 255) | ((unsigned)(q1 & 255) << 8) | ((unsigned)(q2 & 255) << 16) | ((unsigned)(q3 & 255) << 24); }
        unsigned char* dst = Fws + WS_WEGU + ((size_t)e * 2 * FFE + gu_row(n0, FFE) + n) * D + k0 + 32 * hf;
        *(GAS v4u*)dst = (v4u){w[0], w[1], w[2], w[3]}; *(GAS v4u*)(dst + 16) = (v4u){w[4], w[5], w[6], w[7]};
        LDS_WAIT(); asm volatile("" ::: "memory");
    }
}

__device__ __forceinline__ void rowquant_phase(const Frame& F0) {
    const Frame F = refresh(F0);
    const AS4 Args* A_ = kargs(); unsigned char* const Fws = A_->ws; const bf16* XB = (const bf16*)(Fws + WS_XB); unsigned char* XQ = Fws + WS_XQ; float* xsc = (float*)(Fws + WS_XS);
    const int gw = F.vcu * NWAVES + F.wave, NGW = F.G * NWAVES, rpw = (M + NGW - 1) / NGW;
    for (int m = gw * rpw; m < M && m < (gw + 1) * rpw; ++m) {
        const v4u* src = (const v4u*)(XB + (size_t)m * D) + 2 * F.lane; const v4u a = src[0], b = src[1];
        float f[16]; { float t0[8], t1[8]; unpack8(a, t0); unpack8(b, t1);
#pragma unroll
            for (int i = 0; i < 8; ++i) { f[i] = t0[i]; f[8 + i] = t1[i]; } }
        float mx = 0.f, ss = 0.f;
#pragma unroll
        for (int i = 0; i < 16; ++i) { mx = fmaxf(mx, fabsf(f[i])); ss += f[i] * f[i]; }
#pragma unroll
        for (int o = 1; o < 64; o <<= 1) mx = fmaxf(mx, __shfl_xor(mx, o));
        ss = wave_sum(ss);
        const float sa = mx > 0.f ? mx * (1.0f / 127.0f) : 1.f, inv = 1.0f / sa; unsigned w[4];
#pragma unroll
        for (int j = 0; j < 4; ++j) { const int q0 = (int)rintf(f[4 * j] * inv), q1 = (int)rintf(f[4 * j + 1] * inv), q2 = (int)rintf(f[4 * j + 2] * inv), q3 = (int)rintf(f[4 * j + 3] * inv);
            w[j] = (unsigned)(q0 & 255) | ((unsigned)(q1 & 255) << 8) | ((unsigned)(q2 & 255) << 16) | ((unsigned)(q3 & 255) << 24); }
        *((v4u*)(XQ + (size_t)m * D) + F.lane) = (v4u){w[0], w[1], w[2], w[3]};
        if (F.lane == 0) xsc[m] = sa / sqrtf(ss * (1.0f / D) + RMS_EPS);
    }
}

__device__ __forceinline__ int router_phase(const Frame& F0) {
    const Frame F = refresh(F0);
    const AS4 Args* A_ = kargs(); unsigned char* const Fws = A_->ws; gu32* const Fctl = (gu32*)(Fws + WS_CTL); const bf16* xr_ = (const bf16*)(Fws + WS_XB); const float* Wr = A_->in[I_ROUTER]; const float* gff = A_->in[I_FFNG] + D;
    const int gw = F.vcu * NWAVES + F.wave, NGW = F.G * NWAVES, rpw = (M + NGW - 1) / NGW;
    unsigned* toke = (unsigned*)(Fws + WS_TOKE); float* tokg = (float*)(Fws + WS_TOKG); float* tokr = (float*)(Fws + WS_TOKR);
    int mycnt = 0;
    const int r0 = gw * rpw, r1 = (r0 + rpw < M) ? r0 + rpw : M;
    float wg[16][8];
#pragma unroll
    for (int j = 0; j < 4; ++j) { const int k0 = 4 * F.lane + 256 * j; const f32x4 gk = *(const f32x4*)(gff + k0);
#pragma unroll
        for (int c = 0; c < 4; ++c) { const f32x4 a = *(const f32x4*)(Wr + (size_t)(k0 + c) * 8), b = *(const f32x4*)(Wr + (size_t)(k0 + c) * 8 + 4);
            wg[4 * j + c][0] = a[0] * gk[c]; wg[4 * j + c][1] = a[1] * gk[c]; wg[4 * j + c][2] = a[2] * gk[c]; wg[4 * j + c][3] = a[3] * gk[c];
            wg[4 * j + c][4] = b[0] * gk[c]; wg[4 * j + c][5] = b[1] * gk[c]; wg[4 * j + c][6] = b[2] * gk[c]; wg[4 * j + c][7] = b[3] * gk[c]; } }
    const bool b5 = (F.lane & 32) != 0, b4 = (F.lane & 16) != 0, b3 = (F.lane & 8) != 0;
    u32x2_t nx[4] = {};
    if (r0 < r1) { const u32x2_t* xr = (const u32x2_t*)(xr_ + (size_t)r0 * D) + F.lane;
#pragma unroll
        for (int j = 0; j < 4; ++j) nx[j] = xr[64 * j]; }
#pragma unroll 1
    for (int m = r0; m < r1; ++m) {
        u32x2_t cx[4];
#pragma unroll
        for (int j = 0; j < 4; ++j) cx[j] = nx[j];
        if (m + 1 < r1) { const u32x2_t* xr = (const u32x2_t*)(xr_ + (size_t)(m + 1) * D) + F.lane;
#pragma unroll
            for (int j = 0; j < 4; ++j) nx[j] = xr[64 * j]; }
        float lg[8] = {0.f, 0.f, 0.f, 0.f, 0.f, 0.f, 0.f, 0.f}; float ss = 0.f;
#pragma unroll
        for (int j = 0; j < 4; ++j) { const f32x4 v = {__uint_as_float(cx[j].x << 16), __uint_as_float(cx[j].x & 0xffff0000u), __uint_as_float(cx[j].y << 16), __uint_as_float(cx[j].y & 0xffff0000u)};
            ss += (v[0] * v[0] + v[1] * v[1]) + (v[2] * v[2] + v[3] * v[3]);
#pragma unroll
            for (int c = 0; c < 4; ++c)
#pragma unroll
                for (int e = 0; e < 8; ++e) lg[e] += v[c] * wg[4 * j + c][e]; }
        float r4[4], r2[2], r1_;
#pragma unroll
        for (int i = 0; i < 4; ++i) { const float keep = b5 ? lg[i + 4] : lg[i], send = b5 ? lg[i] : lg[i + 4]; r4[i] = keep + __shfl_xor(send, 32); }
#pragma unroll
        for (int i = 0; i < 2; ++i) { const float keep = b4 ? r4[i + 2] : r4[i], send = b4 ? r4[i] : r4[i + 2]; r2[i] = keep + __shfl_xor(send, 16); }
        { const float keep = b3 ? r2[1] : r2[0], send = b3 ? r2[0] : r2[1]; r1_ = keep + __shfl_xor(send, 8); }
        r1_ += __shfl_xor(r1_, 4); r1_ += __shfl_xor(r1_, 2); r1_ += __shfl_xor(r1_, 1);
        ss = wave_sum(ss); const float rs = 1.0f / sqrtf(ss * (1.0f / D) + RMS_EPS);
        float le[8];
#pragma unroll
        for (int e = 0; e < 8; ++e) le[e] = __uint_as_float(__builtin_amdgcn_readlane(__float_as_uint(r1_), 8 * e)) * rs;
        int e1 = 0; float v1 = le[0];
#pragma unroll
        for (int e = 1; e < 8; ++e) if (le[e] > v1) { v1 = le[e]; e1 = e; }
        int e2 = -1; float v2 = -INFINITY;
#pragma unroll
        for (int e = 0; e < 8; ++e) if (e != e1 && le[e] > v2) { v2 = le[e]; e2 = e; }
        if (e2 < 0) e2 = (e1 == 0) ? 1 : 0;
        const float ex = expf(v2 - v1), g1 = 1.0f / (1.0f + ex), g2 = ex * g1;
        if (F.lane == 0) { toke[m] = (unsigned)e1 | ((unsigned)e2 << 8); tokg[2 * m] = g1; tokg[2 * m + 1] = g2; tokr[m] = rs; }
        mycnt += (F.lane == e1) ? 1 : 0; mycnt += (F.lane == e2) ? 1 : 0;
    }
    if (F.lane < 8 && mycnt) __hip_atomic_fetch_add((unsigned*)(Fctl + CW_CNT) + F.lane, (unsigned)mycnt, __ATOMIC_RELAXED, __HIP_MEMORY_SCOPE_AGENT);
    return mycnt;
}
__device__ __forceinline__ int moe_bases(const Frame& F0, int& total) {
    const Frame F = refresh(F0);
    const AS4 Args* A_ = kargs(); gu32* const Fctl = (gu32*)(A_->ws + WS_CTL);
    const unsigned c8 = __hip_atomic_load((unsigned*)(Fctl + CW_CNT) + (F.lane & 7), __ATOMIC_RELAXED, __HIP_MEMORY_SCOPE_AGENT);
    const int rp = (int)((c8 + 255u) & ~255u); int pb = 0, tot = 0;
#pragma unroll
    for (int k = 0; k < 8; ++k) { const int v = __shfl(rp, k); tot += v; if (k < (F.lane & 7)) pb += v; }
    total = tot; return pb;
}
__device__ __forceinline__ void gather_phase(const Frame& F0, int mycnt) {
    const Frame F = refresh(F0);
    const AS4 Args* A_ = kargs(); unsigned char* const Fws = A_->ws; gu32* const Fctl = (gu32*)(Fws + WS_CTL);
    const int gw = F.vcu * NWAVES + F.wave, NGW = F.G * NWAVES, rpw = (M + NGW - 1) / NGW;
    const unsigned* toke = (const unsigned*)(Fws + WS_TOKE); const float* tokr = (const float*)(Fws + WS_TOKR);
    int* pos = (int*)(Fws + WS_POS); float* rsg = (float*)(Fws + WS_RSG);
    const bf16* XB = (const bf16*)(Fws + WS_XB); bf16* XG = (bf16*)(Fws + WS_XG);
    const unsigned* wmaxp = (const unsigned*)((gu32*)(Fws + WS_CTL) + CW_WMAX); float wmax8[8];
#pragma unroll
    for (int e = 0; e < 8; ++e) wmax8[e] = __uint_as_float(wmaxp[64 * e]);
    int total; int wb = moe_bases(F, total);
    if (F.lane < 8 && mycnt) wb += (int)__hip_atomic_fetch_add((unsigned*)(Fctl + CW_CUR) + F.lane, (unsigned)mycnt, __ATOMIC_RELAXED, __HIP_MEMORY_SCOPE_AGENT);
    const int r0 = gw * rpw, r1 = (r0 + rpw < M) ? r0 + rpw : M;
    for (int m = r0; m < r1; ++m) {
        const unsigned ee = toke[m]; const int e1 = (int)(ee & 255u), e2 = (int)(ee >> 8);
        const int s1 = __shfl(wb, e1); if (F.lane == e1) ++wb;
        const int s2 = __shfl(wb, e2); if (F.lane == e2) ++wb;
        const v4u* src = (const v4u*)(XB + (size_t)m * D) + 2 * F.lane; const v4u a = src[0], b = src[1];
        float f[16]; { float t0[8], t1[8]; unpack8(a, t0); unpack8(b, t1);
#pragma unroll
            for (int i = 0; i < 8; ++i) { f[i] = t0[i]; f[8 + i] = t1[i]; } }
        float mx = 0.f;
#pragma unroll
        for (int i = 0; i < 16; ++i) mx = fmaxf(mx, fabsf(f[i]));
#pragma unroll
        for (int o = 1; o < 64; o <<= 1) mx = fmaxf(mx, __shfl_xor(mx, o));
        const float sa = mx > 0.f ? mx * (1.0f / 127.0f) : 1.f, inv = 1.0f / sa; unsigned w[4];
#pragma unroll
        for (int j = 0; j < 4; ++j) { const int q0 = (int)rintf(f[4 * j] * inv), q1 = (int)rintf(f[4 * j + 1] * inv), q2 = (int)rintf(f[4 * j + 2] * inv), q3 = (int)rintf(f[4 * j + 3] * inv);
            w[j] = (unsigned)(q0 & 255) | ((unsigned)(q1 & 255) << 8) | ((unsigned)(q2 & 255) << 16) | ((unsigned)(q3 & 255) << 24); }
        const v4u qv = {w[0], w[1], w[2], w[3]};
        *((v4u*)((unsigned char*)XG + (size_t)s1 * D) + F.lane) = qv; *((v4u*)((unsigned char*)XG + (size_t)s2 * D) + F.lane) = qv;
        if (F.lane == 0) { const float r = tokr[m] * sa * (1.0f / 127.0f); pos[2 * m] = s1; pos[2 * m + 1] = s2; rsg[s1] = r * wmax8[e1]; rsg[s2] = r * wmax8[e2]; }
    }
}
__device__ __forceinline__ void combine_phase(const Frame& F0) {
    const Frame F = refresh(F0);
    const AS4 Args* A_ = kargs(); unsigned char* const Fws = A_->ws; const bf16* xr_ = (const bf16*)(Fws + WS_XB); float* out = A_->out; const float* gfin = A_->in[I_FING];
    const int gw = F.vcu * NWAVES + F.wave, NGW = F.G * NWAVES;
    const float* tokg = (const float*)(Fws + WS_TOKG); const int* pos = (const int*)(Fws + WS_POS); const bf16* Y = (const bf16*)(Fws + WS_XG);
    f32x4 gf[4];
#pragma unroll
    for (int j = 0; j < 4; ++j) gf[j] = ((const f32x4*)gfin)[F.lane + 64 * j];
    for (int m = gw; m < M; m += NGW) {
        const int s1 = pos[2 * m], s2 = pos[2 * m + 1]; const float g1 = tokg[2 * m], g2 = tokg[2 * m + 1];
        const u32x2_t* xr = (const u32x2_t*)(xr_ + (size_t)m * D) + F.lane;
        const u32x2_t* y1 = (const u32x2_t*)(Y + (size_t)s1 * D) + F.lane; const u32x2_t* y2 = (const u32x2_t*)(Y + (size_t)s2 * D) + F.lane;
        f32x4 v[4]; float ss = 0.f;
#pragma unroll
        for (int j = 0; j < 4; ++j) { const u32x2_t xw = xr[64 * j]; const f32x4 xv = {__uint_as_float(xw.x << 16), __uint_as_float(xw.x & 0xffff0000u), __uint_as_float(xw.y << 16), __uint_as_float(xw.y & 0xffff0000u)}; const u32x2_t a = y1[64 * j], b = y2[64 * j];
            v[j][0] = xv[0] + g1 * __uint_as_float(a.x << 16) + g2 * __uint_as_float(b.x << 16);
            v[j][1] = xv[1] + g1 * __uint_as_float(a.x & 0xffff0000u) + g2 * __uint_as_float(b.x & 0xffff0000u);
            v[j][2] = xv[2] + g1 * __uint_as_float(a.y << 16) + g2 * __uint_as_float(b.y << 16);
            v[j][3] = xv[3] + g1 * __uint_as_float(a.y & 0xffff0000u) + g2 * __uint_as_float(b.y & 0xffff0000u);
            ss += (v[j][0] * v[j][0] + v[j][1] * v[j][1]) + (v[j][2] * v[j][2] + v[j][3] * v[j][3]); }
        ss = wave_sum(ss); const float rs = 1.0f / sqrtf(ss * (1.0f / D) + RMS_EPS);
        f32x4* o = (f32x4*)(out + (size_t)m * D) + F.lane;
#pragma unroll
        for (int j = 0; j < 4; ++j) o[64 * j] = v[j] * rs * gf[j];
    }
}

#ifndef ATTN_VARIANT
#define ATTN_VARIANT 3
#endif
#if ATTN_VARIANT == 3
#define ATTN_UNIT attn_unit3
#else
#define ATTN_UNIT attn_unit
#endif
#ifndef PHASE_MASK
#define PHASE_MASK 0xFFFF
#endif
#define PH(b) ((PHASE_MASK >> (b)) & 1)
__global__ void __launch_bounds__(NWAVES * 64, 2) mega_fwd(Args args) {
    extern __shared__ __attribute__((aligned(16))) unsigned char lds[];
    Frame F;
    F.lds = (LAS unsigned char*)lds;
    F.MISC = (volatile LAS unsigned*)(F.lds + MISC_OFF);
    F.tid = threadIdx.x; F.lane = F.tid & 63; F.wave = __builtin_amdgcn_readfirstlane(F.tid >> 6);
    F.G = gridDim.x; { const int bx = blockIdx.x; F.vcu = (F.G % 8 == 0) ? (bx % 8) * (F.G / 8) + bx / 8 : bx; }
    for (int u = F.tid; u < (LDS_BYTES - LDSCTL_OFF) / 4; u += NWAVES * 64) ((LAS unsigned*)(F.lds + LDSCTL_OFF))[u] = 0u;
    __syncthreads();
    XcdBarrier bar = xcd_barrier_post((unsigned*)(args.ws + WS_CTL) + CW_BAR, F.MISC + 8);
    if (threadIdx.x == 0) __hip_atomic_fetch_or((unsigned*)(args.ws + WS_CTL) + CW_XMAP + (blockIdx.x & 7), 1u << bar.x, __ATOMIC_RELAXED, __HIP_MEMORY_SCOPE_AGENT);
#define CHAIN_BAR() do { XcdBarrier b2_ = bar; b2_.bar = (unsigned*)(kargs()->ws + WS_CTL) + CW_BAR; asm volatile("" : "+s"(b2_.x)); if (F.MISC[10]) xcd_barrier_local(b2_); else xcd_barrier(b2_); } while (0)
#define GRID_BAR() do { XcdBarrier b2_ = bar; b2_.bar = (unsigned*)(kargs()->ws + WS_CTL) + CW_BAR; asm volatile("" : "+s"(b2_.x)); xcd_barrier(b2_); } while (0)
#define PHASE_PTRS() const AS4 Args* ka = kargs(); unsigned char* const ws = ka->ws; bf16* const XB = (bf16*)(ws + WS_XB); float* const XR = ka->out; float* const ssqp = (float*)(ws + WS_SSQP); bf16* const Z = (bf16*)(ws + WS_ARENA); \
    (void)XB; (void)XR; (void)ssqp; (void)Z
    constexpr size_t ZGE = ZG / 2;

    if (PH(0)) p0_prologue(F);
    GRID_BAR();
    if (threadIdx.x == 0) { unsigned all = 0u, ok = (F.G == 256 && F.MISC[8] == (unsigned)F.G / 8u) ? 1u : 0u;
        for (int j = 0; j < 8; ++j) { const unsigned m_ = __hip_atomic_load((unsigned*)(kargs()->ws + WS_CTL) + CW_XMAP + j, __ATOMIC_RELAXED, __HIP_MEMORY_SCOPE_AGENT); if (__builtin_popcount(m_) != 1) ok = 0u; all |= m_; }
        if (__builtin_popcount(all) != 8) ok = 0u;
        F.MISC[10] = ok; }
    __syncthreads();

    { constexpr int l = 0;
        if (PH(1)) { PHASE_PTRS(); pg8::Gemm g{(const bf16*)(ws + WS_XQ), (const bf16*)(ws + WS_WIN + (size_t)l * INW * D), M, INW, D / 2, (const bf16*)(ws + WS_WIN + (size_t)l * INW * D), (const bf16*)(ws + WS_XQ)}; pg8::InProjOrder S; S.init(M, INW, F.G, (int)blockIdx.x);
          constexpr long BHD = (long)WS_SSQP - (long)WS_XS;
          for (int i_ = 0; i_ < 2 * ((int)blockIdx.x >> 6); ++i_) __builtin_amdgcn_s_sleep(63);
          pg8::EpiInProj<BHD> E{Z, ZGE, (const float*)(ws + WS_XS), (const float*)(ws + WS_WCS) + l * INW, C2, (unsigned*)(ws + WS_CTL) + CW_KMAX + l * 32, (F.G == 256 && pg8::WGM == 8 && pg8::NXCD == 8) ? ka->in[I_CONVW] + (size_t)l * 3 * D : (const float*)nullptr};
          pg8::gemm_phase<pg8::EpiInProj<BHD>, pg8::InProjOrder, true, true, true>(F.lds + RING_OFF, g, S, E, F.wave); }
        GRID_BAR();
        if (PH(2)) { conv_phase(F, l); if (l == 0) wq_phase(F); }
        if (PH(3)) { PHASE_PTRS(); const float* par = (const float*)(ws + WS_PAR);
          const float* gsub = ka->in[I_SUBLN] + l * 128; const float* relb = ka->in[I_RELB];
#ifdef PROBE_ATTN2
          for (int rep_ = 0; rep_ < 2; ++rep_) {
#else
          {
#endif
          { const int nun = (F.G == 256) ? 8 : (2048 - F.vcu + F.G - 1) / F.G;
              dattn::bf16x8 qn[4];
              { int bh, qb; if (F.G == 256) { bh = F.vcu >> 4; qb = F.vcu & 15; } else { bh = F.vcu >> 7; qb = F.vcu & 127; } dattn::attn_qload(qn, bh >> 3, bh & 7, qb, Z, F.wave); }
#pragma unroll 1
              for (int r = 0; r < nun; ++r) { int bh, qb, nbh, nqb; const int rn = (r + 1 < nun) ? r + 1 : r;
                  if (F.G == 256) { const int c = F.vcu & 15; bh = nbh = F.vcu >> 4; qb = 16 * r + ((r & 1) ? 15 - c : c); nqb = 16 * rn + ((rn & 1) ? 15 - c : c); } else { const int L = F.vcu + r * F.G, Ln = F.vcu + rn * F.G; bh = L >> 7; qb = L & 127; nbh = Ln >> 7; nqb = Ln & 127; }
                  dattn::ATTN_UNIT(bh >> 3, bh & 7, qb, qn, nbh >> 3, nbh & 7, nqb, Z, Z + ZGE, Z + 2 * ZGE, Z, relb, par, l, gsub, (char*)lds + RING_OFF, F.wave, (const unsigned*)(ws + WS_CTL) + CW_KMAX + l * 32 + (bh >> 3) * 16);     } }
          }
          asm volatile("s_waitcnt vmcnt(0) lgkmcnt(0)\n\ts_barrier" ::: "memory"); }
        GRID_BAR();
        if (PH(4)) { PHASE_PTRS(); pg8::Gemm g{Z, (const bf16*)(ws + WS_WSM) + (size_t)(l * 3 + 0) * D * D, M, D, D, Z + 4 * ZGE, (const bf16*)(ws + WS_WSM) + (size_t)(l * 3 + 1) * D * D};
          pg8::PairOrder S; S.init(M, D, F.G, (int)blockIdx.x);
          pg8::EpiGateFused E{(const unsigned char*)(Z + 6 * ZGE), (const unsigned char*)(Z + 7 * ZGE), Z + 5 * ZGE};
          pg8::gemm_phase<pg8::EpiGateFused, pg8::PairOrder, true, true>(F.lds + RING_OFF, g, S, E, F.wave); }
        CHAIN_BAR();
        if (PH(6)) { PHASE_PTRS(); pg8::Gemm g{Z + 5 * ZGE, (const bf16*)(ws + WS_WSM) + (size_t)(l * 3 + 2) * D * D, M, D, D}; pg8::StaticOrder S; S.init(M, D, F.G, (int)blockIdx.x);
          pg8::EpiResid<l == 0> E{ka->in[I_X], XB, 1.f};
          pg8::gemm_phase<pg8::EpiResid<l == 0>, pg8::StaticOrder, true, true>(F.lds + RING_OFF, g, S, E, F.wave); }
        CHAIN_BAR();
        if (l == 0) {
            rowquant_phase(F);
            CHAIN_BAR();
            if (PH(7)) { PHASE_PTRS(); pg8::Gemm g{(const bf16*)(ws + WS_XQ), (const bf16*)(ws + WS_WGU), M, 2 * FFD, D / 2}; pg8::StaticOrder S; S.init(M, 2 * FFD, F.G, (int)blockIdx.x);
              pg8::EpiSwiGLU<pg8::RowScaleDirect, true, true> E{(bf16*)(ws + WS_HD), FFD, pg8::RowScaleDirect{(const float*)(ws + WS_XS)}, (const float*)(ws + WS_GCS), H8_SCALE};
              pg8::gemm_phase<pg8::EpiSwiGLU<pg8::RowScaleDirect, true, true>, pg8::StaticOrder, true, true, true>(F.lds + RING_OFF, g, S, E, F.wave); }
            CHAIN_BAR();
            if (PH(8)) { PHASE_PTRS(); pg8::Gemm g{(const bf16*)(ws + WS_HD), (const bf16*)(ws + WS_WDN), M, D, FFD / 2}; pg8::StaticOrder S; S.init(M, D, F.G, (int)blockIdx.x);
              pg8::EpiResid<false> E{nullptr, XB, 1.0f / (H8_SCALE * WD8_SCALE)};
              pg8::gemm_phase<pg8::EpiResid<false>, pg8::StaticOrder, true, true, false, true>(F.lds + RING_OFF, g, S, E, F.wave); }
            CHAIN_BAR();
            rowquant_phase(F);
            CHAIN_BAR();
        } else {
            const int mycnt = PH(9) ? router_phase(F) : 0;
            GRID_BAR();
            if (PH(10)) gather_phase(F, mycnt);
            GRID_BAR();
            if (PH(11)) { PHASE_PTRS(); int total; const int pb = moe_bases(F, total); const int npan = __builtin_amdgcn_readfirstlane(total) >> 8;
              pg8::Gemm g{(const bf16*)(ws + WS_XG), (const bf16*)(ws + WS_WEGU), SLOTS, 2 * FFE, D / 2}; pg8::MoeOrder S; S.init(npan, 2 * FFE, F.G, (int)blockIdx.x, 2 * FFE);
#pragma unroll
              for (int k = 0; k < 8; ++k) S.ps[k] = __builtin_amdgcn_readfirstlane(__shfl(pb, k)) >> 8;
              pg8::EpiSwiGLU<pg8::RowScaleDirect, false, true> E{(bf16*)(ws + WS_HE), FFE, pg8::RowScaleDirect{(const float*)(ws + WS_RSG)}, nullptr, H8_SCALE};
              pg8::gemm_phase<pg8::EpiSwiGLU<pg8::RowScaleDirect, false, true>, pg8::MoeOrder, true, true, true>(F.lds + RING_OFF, g, S, E, F.wave); }
            GRID_BAR();
            if (PH(12)) { PHASE_PTRS(); int total; const int pb = moe_bases(F, total); const int npan = __builtin_amdgcn_readfirstlane(total) >> 8;
              pg8::Gemm g{(const bf16*)(ws + WS_HE), (const bf16*)(ws + WS_WEDN), SLOTS, D, FFE / 2}; pg8::MoeOrder S; S.init(npan, D, F.G, (int)blockIdx.x, D);
#pragma unroll
              for (int k = 0; k < 8; ++k) S.ps[k] = __builtin_amdgcn_readfirstlane(__shfl(pb, k)) >> 8;
              pg8::EpiPlainBf16 E{(bf16*)(ws + WS_XG), D, 1.0f / (H8_SCALE * WD8_SCALE)};
              pg8::gemm_phase<pg8::EpiPlainBf16, pg8::MoeOrder, true, true, false, true>(F.lds + RING_OFF, g, S, E, F.wave); }
            GRID_BAR();
            if (PH(13)) combine_phase(F);
        }
        }
    { constexpr int l = 1;
        if (PH(1)) { PHASE_PTRS(); pg8::Gemm g{(const bf16*)(ws + WS_XQ), (const bf16*)(ws + WS_WIN + (size_t)l * INW * D), M, INW, D / 2, (const bf16*)(ws + WS_WIN + (size_t)l * INW * D), (const bf16*)(ws + WS_XQ)}; pg8::InProjOrder S; S.init(M, INW, F.G, (int)blockIdx.x);
          constexpr long BHD = (long)WS_SSQP - (long)WS_XS;
          for (int i_ = 0; i_ < 2 * ((int)blockIdx.x >> 6); ++i_) __builtin_amdgcn_s_sleep(63);
          pg8::EpiInProj<BHD> E{Z, ZGE, (const float*)(ws + WS_XS), (const float*)(ws + WS_WCS) + l * INW, C2, (unsigned*)(ws + WS_CTL) + CW_KMAX + l * 32, (F.G == 256 && pg8::WGM == 8 && pg8::NXCD == 8) ? ka->in[I_CONVW] + (size_t)l * 3 * D : (const float*)nullptr};
          pg8::gemm_phase<pg8::EpiInProj<BHD>, pg8::InProjOrder, true, true, true>(F.lds + RING_OFF, g, S, E, F.wave); }
        GRID_BAR();
        if (PH(2)) { conv_phase(F, l); if (l == 0) wq_phase(F); }
        if (PH(3)) { PHASE_PTRS(); const float* par = (const float*)(ws + WS_PAR);
          const float* gsub = ka->in[I_SUBLN] + l * 128; const float* relb = ka->in[I_RELB];
#ifdef PROBE_ATTN2
          for (int rep_ = 0; rep_ < 2; ++rep_) {
#else
          {
#endif
          { const int nun = (F.G == 256) ? 8 : (2048 - F.vcu + F.G - 1) / F.G;
              dattn::bf16x8 qn[4];
              { int bh, qb; if (F.G == 256) { bh = F.vcu >> 4; qb = F.vcu & 15; } else { bh = F.vcu >> 7; qb = F.vcu & 127; } dattn::attn_qload(qn, bh >> 3, bh & 7, qb, Z, F.wave); }
#pragma unroll 1
              for (int r = 0; r < nun; ++r) { int bh, qb, nbh, nqb; const int rn = (r + 1 < nun) ? r + 1 : r;
                  if (F.G == 256) { const int c = F.vcu & 15; bh = nbh = F.vcu >> 4; qb = 16 * r + ((r & 1) ? 15 - c : c); nqb = 16 * rn + ((rn & 1) ? 15 - c : c); } else { const int L = F.vcu + r * F.G, Ln = F.vcu + rn * F.G; bh = L >> 7; qb = L & 127; nbh = Ln >> 7; nqb = Ln & 127; }
                  dattn::ATTN_UNIT(bh >> 3, bh & 7, qb, qn, nbh >> 3, nbh & 7, nqb, Z, Z + ZGE, Z + 2 * ZGE, Z, relb, par, l, gsub, (char*)lds + RING_OFF, F.wave, (const unsigned*)(ws + WS_CTL) + CW_KMAX + l * 32 + (bh >> 3) * 16);     } }
          }
          asm volatile("s_waitcnt vmcnt(0) lgkmcnt(0)\n\ts_barrier" ::: "memory"); }
        GRID_BAR();
        if (PH(4)) { PHASE_PTRS(); pg8::Gemm g{Z, (const bf16*)(ws + WS_WSM) + (size_t)(l * 3 + 0) * D * D, M, D, D, Z + 4 * ZGE, (const bf16*)(ws + WS_WSM) + (size_t)(l * 3 + 1) * D * D};
          pg8::PairOrder S; S.init(M, D, F.G, (int)blockIdx.x);
          pg8::EpiGateFused E{(const unsigned char*)(Z + 6 * ZGE), (const unsigned char*)(Z + 7 * ZGE), Z + 5 * ZGE};
          pg8::gemm_phase<pg8::EpiGateFused, pg8::PairOrder, true, true>(F.lds + RING_OFF, g, S, E, F.wave); }
        CHAIN_BAR();
        if (PH(6)) { PHASE_PTRS(); pg8::Gemm g{Z + 5 * ZGE, (const bf16*)(ws + WS_WSM) + (size_t)(l * 3 + 2) * D * D, M, D, D}; pg8::StaticOrder S; S.init(M, D, F.G, (int)blockIdx.x);
          pg8::EpiResid<l == 0> E{ka->in[I_X], XB, 1.f};
          pg8::gemm_phase<pg8::EpiResid<l == 0>, pg8::StaticOrder, true, true>(F.lds + RING_OFF, g, S, E, F.wave); }
        CHAIN_BAR();
        if (l == 0) {
            rowquant_phase(F);
            CHAIN_BAR();
            if (PH(7)) { PHASE_PTRS(); pg8::Gemm g{(const bf16*)(ws + WS_XQ), (const bf16*)(ws + WS_WGU), M, 2 * FFD, D / 2}; pg8::StaticOrder S; S.init(M, 2 * FFD, F.G, (int)blockIdx.x);
              pg8::EpiSwiGLU<pg8::RowScaleDirect, true, true> E{(bf16*)(ws + WS_HD), FFD, pg8::RowScaleDirect{(const float*)(ws + WS_XS)}, (const float*)(ws + WS_GCS), H8_SCALE};
              pg8::gemm_phase<pg8::EpiSwiGLU<pg8::RowScaleDirect, true, true>, pg8::StaticOrder, true, true, true>(F.lds + RING_OFF, g, S, E, F.wave); }
            CHAIN_BAR();
            if (PH(8)) { PHASE_PTRS(); pg8::Gemm g{(const bf16*)(ws + WS_HD), (const bf16*)(ws + WS_WDN), M, D, FFD / 2}; pg8::StaticOrder S; S.init(M, D, F.G, (int)blockIdx.x);
              pg8::EpiResid<false> E{nullptr, XB, 1.0f / (H8_SCALE * WD8_SCALE)};
              pg8::gemm_phase<pg8::EpiResid<false>, pg8::StaticOrder, true, true, false, true>(F.lds + RING_OFF, g, S, E, F.wave); }
            CHAIN_BAR();
            rowquant_phase(F);
            CHAIN_BAR();
        } else {
            const int mycnt = PH(9) ? router_phase(F) : 0;
            GRID_BAR();
            if (PH(10)) gather_phase(F, mycnt);
            GRID_BAR();
            if (PH(11)) { PHASE_PTRS(); int total; const int pb = moe_bases(F, total); const int npan = __builtin_amdgcn_readfirstlane(total) >> 8;
              pg8::Gemm g{(const bf16*)(ws + WS_XG), (const bf16*)(ws + WS_WEGU), SLOTS, 2 * FFE, D / 2}; pg8::MoeOrder S; S.init(npan, 2 * FFE, F.G, (int)blockIdx.x, 2 * FFE);
#pragma unroll
              for (int k = 0; k < 8; ++k) S.ps[k] = __builtin_amdgcn_readfirstlane(__shfl(pb, k)) >> 8;
              pg8::EpiSwiGLU<pg8::RowScaleDirect, false, true> E{(bf16*)(ws + WS_HE), FFE, pg8::RowScaleDirect{(const float*)(ws + WS_RSG)}, nullptr, H8_SCALE};
              pg8::gemm_phase<pg8::EpiSwiGLU<pg8::RowScaleDirect, false, true>, pg8::MoeOrder, true, true, true>(F.lds + RING_OFF, g, S, E, F.wave); }
            GRID_BAR();
            if (PH(12)) { PHASE_PTRS(); int total; const int pb = moe_bases(F, total); const int npan = __builtin_amdgcn_readfirstlane(total) >> 8;
              pg8::Gemm g{(const bf16*)(ws + WS_HE), (const bf16*)(ws + WS_WEDN), SLOTS, D, FFE / 2}; pg8::MoeOrder S; S.init(npan, D, F.G, (int)blockIdx.x, D);
#pragma unroll
              for (int k = 0; k < 8; ++k) S.ps[k] = __builtin_amdgcn_readfirstlane(__shfl(pb, k)) >> 8;
              pg8::EpiPlainBf16 E{(bf16*)(ws + WS_XG), D, 1.0f / (H8_SCALE * WD8_SCALE)};
              pg8::gemm_phase<pg8::EpiPlainBf16, pg8::MoeOrder, true, true, false, true>(F.lds + RING_OFF, g, S, E, F.wave); }
            GRID_BAR();
            if (PH(13)) combine_phase(F);
        }
        }
#undef GRID_BAR
#undef CHAIN_BAR
#undef PHASE_PTRS
}

extern "C" void kernel_launch(void* const* d_in, const int* in_sizes, int n_in, void* d_out, int out_size, void* d_ws, size_t ws_size, hipStream_t stream) {
    static int grid = 0;
    if (grid == 0) {
        if (n_in != 17 || in_sizes[0] != M * D || out_size != M * D || ws_size < WS_END) { fprintf(stderr, "kernel_launch: shape/workspace mismatch: n_in %d in0 %d out %d ws %zu (need %zu)\n", n_in, n_in > 0 ? in_sizes[0] : -1, out_size, ws_size, (size_t)WS_END); grid = -1; return; }
        int dev = 0, cus = 0, per_cu = 0;
        if (hipGetDevice(&dev) != hipSuccess || hipDeviceGetAttribute(&cus, hipDeviceAttributeMultiprocessorCount, dev) != hipSuccess) { grid = -1; return; }
        if (hipFuncSetAttribute((const void*)mega_fwd, hipFuncAttributeMaxDynamicSharedMemorySize, LDS_BYTES) != hipSuccess) { fprintf(stderr, "kernel_launch: hipFuncSetAttribute failed\n"); grid = -1; return; }
        if (hipOccupancyMaxActiveBlocksPerMultiprocessor(&per_cu, (const void*)mega_fwd, NWAVES * 64, LDS_BYTES) != hipSuccess || per_cu < 1) { fprintf(stderr, "kernel_launch: occupancy query reports %d\n", per_cu); }
        (void)hipGetLastError();
        grid = cus;
    }
    if (grid < 0) return;
    if (hipMemsetAsync((char*)d_ws + WS_CTL, 0, CTL_ZERO_BYTES, stream) != hipSuccess) return;
    Args a{};
    for (int i = 0; i < 17; ++i) a.in[i] = (const float*)d_in[i];
    a.out = (float*)d_out; a.ws = (unsigned char*)d_ws;
    hipLaunchKernelGGL(mega_fwd, dim3(grid), dim3(NWAVES * 64), LDS_BYTES, stream, a);
    const hipError_t le = hipPeekAtLastError();
    if (le != hipSuccess) fprintf(stderr, "kernel_launch: launch failed: %s\n", hipGetErrorName(le));
}
```
